# Optimizing an MI355X kernel written in HIP

```python
import jax, jax.numpy as jnp
from jax import lax
import numpy as np

D_MODEL = 1024
BATCH = 2
SEQ = 16384
DEPTH = 2

N_A_LAYERS = DEPTH // 2
N_B_LAYERS = DEPTH - N_A_LAYERS
POOL_WINDOWS = (2, 4, 8, 16)
N_POOL_GROUPS = len(POOL_WINDOWS)
POOL_GROUP = D_MODEL // N_POOL_GROUPS
HEAD_DIM = 128
N_HEADS = D_MODEL // HEAD_DIM
MOBA_BLOCK = 256
MOBA_TOPK = 3
Q_CHUNK = 64
D_FF = ((8 * D_MODEL // 3 + 255) // 256) * 256
ROPE_THETA = 10000.0
EPS = 1e-6
N_SUBLAYERS = 3
N_MOD = 3 * N_SUBLAYERS
MACARON_WEIGHT = 0.5

kernel_name = "yoco_pool_moba_macaron_adaln"


def rms_norm(x, g):
    xf = x.astype(jnp.float32)
    y = xf * lax.rsqrt(jnp.mean(xf * xf, axis=-1, keepdims=True) + EPS)
    return (y * g.astype(jnp.float32)).astype(x.dtype)


def modulate(h, shift, scale):
    return h * (1.0 + scale[:, None, :]) + shift[:, None, :]


def swiglu(h, w_in, w_out):
    gu = h @ w_in
    g, u = jnp.split(gu, 2, axis=-1)
    return (jax.nn.silu(g) * u) @ w_out


def rope_tables(T):
    pos = jnp.arange(T, dtype=jnp.float32)
    inv = ROPE_THETA ** (-jnp.arange(0, HEAD_DIM, 2, dtype=jnp.float32) / HEAD_DIM)
    ang = pos[:, None] * inv[None, :]
    return jnp.cos(ang), jnp.sin(ang)


def rope(x, cos, sin):
    half = HEAD_DIM // 2
    xf = x.astype(jnp.float32)
    x1, x2 = xf[..., :half], xf[..., half:]
    c = cos[None, :, None, :]
    s = sin[None, :, None, :]
    return jnp.concatenate([x1 * c - x2 * s, x2 * c + x1 * s], axis=-1).astype(x.dtype)


def pool_mixer(h, w_pool, pool_scale):
    B, T, _ = h.shape
    hg = h.astype(jnp.float32).reshape(B, T, N_POOL_GROUPS, POOL_GROUP)
    cs = jnp.cumsum(hg, axis=1)
    t = jnp.arange(T)
    outs = []
    for gi, w in enumerate(POOL_WINDOWS):
        c_g = cs[:, :, gi]
        prev = jnp.pad(c_g, ((0, 0), (w, 0), (0, 0)))[:, :T]
        cnt = jnp.minimum(t + 1, w).astype(jnp.float32)[None, :, None]
        outs.append((c_g - prev) / cnt - hg[:, :, gi])
    pooled = jnp.stack(outs, axis=2).astype(h.dtype)
    y = jnp.einsum('btgc,gcd->btgd', pooled, w_pool).reshape(B, T, D_MODEL)
    return y * pool_scale


def shared_kv(h, c_silu, kv_norm, kv_ada_w, kv_ada_b, w_kv, k_norm, cos, sin):
    B, T, _ = h.shape
    shift, scale = jnp.split(c_silu @ kv_ada_w + kv_ada_b, 2, axis=-1)
    hn = modulate(rms_norm(h, kv_norm), shift, scale)
    k, v = jnp.split(hn @ w_kv, 2, axis=-1)
    k = rope(rms_norm(k.reshape(B, T, N_HEADS, HEAD_DIM), k_norm), cos, sin)
    v = v.reshape(B, T, N_HEADS, HEAD_DIM)
    nb = -(-T // MOBA_BLOCK)
    pad = nb * MOBA_BLOCK - T
    k = jnp.pad(k.transpose(0, 2, 1, 3), ((0, 0), (0, 0), (0, pad), (0, 0)))
    v = jnp.pad(v.transpose(0, 2, 1, 3), ((0, 0), (0, 0), (0, pad), (0, 0)))
    k_blocks = k.reshape(B, N_HEADS, nb, MOBA_BLOCK, HEAD_DIM)
    v_blocks = v.reshape(B, N_HEADS, nb, MOBA_BLOCK, HEAD_DIM)
    k_mean = jnp.mean(k_blocks.astype(jnp.float32), axis=3).astype(k.dtype)
    return k_blocks, v_blocks, k_mean


def moba_attention(q, k_blocks, v_blocks, k_mean):
    B, H, T, _ = q.shape
    nb = k_blocks.shape[2]
    topk = min(MOBA_TOPK, nb)
    n_chunks = T // Q_CHUNK
    bi = jnp.arange(B)[:, None, None, None]
    hi = jnp.arange(H)[None, :, None, None]
    sm_scale = HEAD_DIM ** -0.5

    def chunk(ci):
        q0 = ci * Q_CHUNK
        qc = lax.dynamic_slice_in_dim(q, q0, Q_CHUNK, axis=2)
        n = q0 // MOBA_BLOCK
        gate = jnp.einsum('bhqd,bhnd->bhqn', qc, k_mean).astype(jnp.float32)
        gate = jnp.where(jnp.arange(nb) < n, gate, -jnp.inf)
        _, idx = lax.top_k(gate, topk)
        valid = jnp.arange(topk) < n
        k_sel = k_blocks[bi, hi, idx]
        v_sel = v_blocks[bi, hi, idx]
        s_sel = jnp.einsum('bhqd,bhqkjd->bhqkj', qc, k_sel).astype(jnp.float32) * sm_scale
        s_sel = jnp.where(valid[:, None], s_sel, -jnp.inf).reshape(B, H, Q_CHUNK, topk * MOBA_BLOCK)
        k_own = lax.dynamic_index_in_dim(k_blocks, n, axis=2, keepdims=False)
        v_own = lax.dynamic_index_in_dim(v_blocks, n, axis=2, keepdims=False)
        s_own = jnp.einsum('bhqd,bhkd->bhqk', qc, k_own).astype(jnp.float32) * sm_scale
        qpos = q0 + jnp.arange(Q_CHUNK)
        kpos = n * MOBA_BLOCK + jnp.arange(MOBA_BLOCK)
        s_own = jnp.where(kpos[None, :] <= qpos[:, None], s_own, -jnp.inf)
        p = jax.nn.softmax(jnp.concatenate([s_sel, s_own], axis=-1), axis=-1).astype(v_blocks.dtype)
        p_sel = p[..., :topk * MOBA_BLOCK].reshape(B, H, Q_CHUNK, topk, MOBA_BLOCK)
        p_own = p[..., topk * MOBA_BLOCK:]
        return (jnp.einsum('bhqkj,bhqkjd->bhqd', p_sel, v_sel)
                + jnp.einsum('bhqk,bhkd->bhqd', p_own, v_own))

    outs = lax.map(chunk, jnp.arange(n_chunks))
    return outs.transpose(1, 2, 0, 3, 4).reshape(B, H, T, HEAD_DIM)


def setup_inputs(seed: int = 0) -> dict:
    key = jax.random.key(seed)
    ks = jax.random.split(key, 20)
    f32 = jnp.float32
    D = D_MODEL
    nrm = lambda k, shape, s: (jax.random.normal(k, shape, f32) * s)
    return {
        "x": nrm(ks[0], (BATCH, SEQ, D), 1.0),
        "c": nrm(ks[1], (BATCH, D), 1.0),
        "ada_w": nrm(ks[2], (DEPTH, D, N_MOD * D), 0.1 * D ** -0.5),
        "ada_b": nrm(ks[3], (DEPTH, N_MOD * D), 0.05),
        "norm_g": 1.0 + nrm(ks[4], (DEPTH, N_SUBLAYERS, D), 0.05),
        "ffn_w_in": nrm(ks[5], (DEPTH, 2, D, 2 * D_FF), D ** -0.5),
        "ffn_w_out": nrm(ks[6], (DEPTH, 2, D_FF, D), D_FF ** -0.5),
        "pool_w": nrm(ks[7], (N_A_LAYERS, N_POOL_GROUPS, POOL_GROUP, POOL_GROUP), POOL_GROUP ** -0.5),
        "pool_scale": 1.0 + nrm(ks[8], (N_A_LAYERS, D), 0.1),
        "kv_norm": 1.0 + nrm(ks[9], (D,), 0.05),
        "kv_ada_w": nrm(ks[10], (D, 2 * D), 0.1 * D ** -0.5),
        "kv_ada_b": nrm(ks[11], (2 * D,), 0.05),
        "w_kv": nrm(ks[12], (D, 2 * D), D ** -0.5),
        "k_norm": 1.0 + nrm(ks[13], (HEAD_DIM,), 0.05),
        "w_q": nrm(ks[14], (N_B_LAYERS, D, D), D ** -0.5),
        "q_norm": 1.0 + nrm(ks[15], (N_B_LAYERS, HEAD_DIM), 0.05),
        "w_o": nrm(ks[16], (N_B_LAYERS, D, D), D ** -0.5),
    }


def reference(x, c, ada_w, ada_b, norm_g, ffn_w_in, ffn_w_out, pool_w, pool_scale,
              kv_norm, kv_ada_w, kv_ada_b, w_kv, k_norm, w_q, q_norm, w_o):
    B, T, D = x.shape
    c_silu = jax.nn.silu(c)
    cos, sin = rope_tables(T)
    kv = None
    for layer in range(DEPTH):
        mods = jnp.split(c_silu @ ada_w[layer] + ada_b[layer], N_MOD, axis=-1)
        sh, sc, g = mods[0], mods[1], mods[2]
        h = modulate(rms_norm(x, norm_g[layer, 0]), sh, sc)
        x = x + MACARON_WEIGHT * (1.0 + g)[:, None, :] * swiglu(h, ffn_w_in[layer, 0], ffn_w_out[layer, 0])
        sh, sc, g = mods[3], mods[4], mods[5]
        h = modulate(rms_norm(x, norm_g[layer, 1]), sh, sc)
        if layer < N_A_LAYERS:
            y = pool_mixer(h, pool_w[layer], pool_scale[layer])
        else:
            j = layer - N_A_LAYERS
            k_blocks, v_blocks, k_mean = kv
            q = (h @ w_q[j]).reshape(B, T, N_HEADS, HEAD_DIM)
            q = rope(rms_norm(q, q_norm[j]), cos, sin).transpose(0, 2, 1, 3)
            att = moba_attention(q, k_blocks, v_blocks, k_mean)
            y = att.transpose(0, 2, 1, 3).reshape(B, T, D) @ w_o[j]
        x = x + (1.0 + g)[:, None, :] * y
        sh, sc, g = mods[6], mods[7], mods[8]
        h = modulate(rms_norm(x, norm_g[layer, 2]), sh, sc)
        x = x + MACARON_WEIGHT * (1.0 + g)[:, None, :] * swiglu(h, ffn_w_in[layer, 1], ffn_w_out[layer, 1])
        if layer == N_A_LAYERS - 1:
            kv = shared_kv(x, c_silu, kv_norm, kv_ada_w, kv_ada_b, w_kv, k_norm, cos, sin)
    return x
```

```cpp
#include <hip/hip_runtime.h>
#include <hip/hip_cooperative_groups.h>
#include <cstdio>
#include <cstdint>
namespace cg = cooperative_groups;

#ifndef MK_COOP
#define MK_COOP 1
#endif

#define LAS __attribute__((address_space(3)))
typedef unsigned short bf16_t;
typedef short bf16x8 __attribute__((ext_vector_type(8)));
typedef float f32x4 __attribute__((ext_vector_type(4)));
typedef float f32x16 __attribute__((ext_vector_type(16)));
typedef unsigned u32x4 __attribute__((ext_vector_type(4)));
typedef unsigned u32x2 __attribute__((ext_vector_type(2)));
typedef float f32x2_t __attribute__((ext_vector_type(2)));
typedef __bf16 bf16x2_t __attribute__((ext_vector_type(2)));

constexpr int BATCH = 2, T = 16384, D = 1024, FF = 2816, NH = 8, HD = 128, NBLK = 64, BS = 256;
constexpr int M = BATCH * T;
constexpr int NIN = 2 * FF;
constexpr float EPS = 1e-6f;
constexpr int NMODCOL = 2 * 9 * D + 2 * D;
constexpr int KSPLIT = 16;

constexpr size_t MiB = 1u << 20;
constexpr size_t WS_CNT = 0;
constexpr size_t WS_BAR = 16384;
constexpr size_t WS_CREF = 8192;
constexpr size_t WS_MODP = 64 * 1024;
constexpr size_t WS_VEC = 3 * MiB;
constexpr size_t WS_BIAS = 3 * MiB + 256 * 1024;
constexpr size_t WS_KMEAN = 3 * MiB + 512 * 1024;
constexpr size_t WS_SSQA = 4 * MiB, WS_SSQB = 6 * MiB;
constexpr size_t WS_ROPE = 8 * MiB;
constexpr size_t WS_LS = 16 * MiB;
constexpr size_t WS_WIN = 20 * MiB;
constexpr size_t WS_WOUT = 64 * MiB;
constexpr size_t WS_WKV = 86 * MiB, WS_WQ = 90 * MiB, WS_WO = 92 * MiB, WS_WPOOL = 94 * MiB;
constexpr size_t WS_XB = 95 * MiB;
constexpr size_t WS_XB2 = 159 * MiB;
constexpr size_t WS_BIG = 223 * MiB;
constexpr size_t WS_KN = WS_BIG, WS_VT = WS_BIG + 64 * MiB, WS_QN = WS_BIG + 128 * MiB;
constexpr size_t WS_SLOT2 = WS_BIG + 192 * MiB;
constexpr size_t WS_LIST = WS_SLOT2 + 32 * MiB;
constexpr size_t WS_END = WS_LIST + 32 * MiB;
static_assert(WS_END <= 512 * MiB, "ws map");

constexpr int LDS_BYTES = 147456;
constexpr int NWAVES = 8;
constexpr int NPH = 21;

__device__ __forceinline__ int lane_id() { int l; asm volatile("v_mbcnt_lo_u32_b32 %0, -1, 0\n\tv_mbcnt_hi_u32_b32 %0, -1, %0" : "=v"(l)); return l; }
__device__ __forceinline__ unsigned cvtpk(float lo, float hi) { f32x2_t v = {lo, hi}; bf16x2_t b = __builtin_convertvector(v, bf16x2_t); return __builtin_bit_cast(unsigned, b); }
__device__ __forceinline__ float bflo(unsigned w) { return __uint_as_float(w << 16); }
__device__ __forceinline__ float bfhi(unsigned w) { return __uint_as_float(w & 0xffff0000u); }
__device__ __forceinline__ float wave_sum(float v) {
#pragma unroll
    for (int o = 1; o < 64; o <<= 1) v += __shfl_xor(v, o);
    return v;
}
__device__ __forceinline__ float rstd_from(const f32x4 a) { return __builtin_amdgcn_rsqf(((a[0] + a[1]) + (a[2] + a[3])) * (1.0f / D) + EPS); }
__device__ __forceinline__ float rstd_of(const float* p) { return rstd_from(*(const f32x4*)p); }
__device__ __forceinline__ float silu_mul(float g, float u) { return g * __builtin_amdgcn_rcpf(1.0f + __builtin_amdgcn_exp2f(-1.4426950408889634f * g)) * u; }

namespace pg8 {
constexpr int BM = 256, BK = 64, HALF = 128, HTB = HALF * BK * 2, STAGE_BYTES = 8 * HTB, NXCD = 8, WGM = 8;
__host__ __device__ __forceinline__ int lds_byte(int r, int c) { const int st = (r >> 4) * 2 + (c >> 5), rr = r & 15, cc = c & 31, ob = rr * 64 + cc * 2; return st * 1024 + (ob ^ (((ob >> 9) & 1) << 5)); }
__host__ __device__ __forceinline__ void stage_rc(int b, int& R, int& C) { const int st = b / 1024, sb = b % 1024, swz = sb ^ (((sb >> 9) & 1) << 5); R = (st >> 1) * 16 + swz / 64; C = (st & 1) * 32 + (swz % 64) / 2; }
__host__ __device__ __forceinline__ int perm32(int rho) { const int n = rho >> 4, i = rho & 15; return 8 * (i >> 2) + 4 * n + (i & 3); }

struct Unit { int pm, pn; };
struct Gemm { const bf16_t* A; const bf16_t* Bt; int M, N, K, lda, acol; };

struct StaticOrder {
    int nM, nN, nwg, G, c;
    __host__ __device__ __forceinline__ void init(int M_, int N_, int G_, int c_, int rev_ = 0) { nM = M_ / BM; nN = N_ / BM; nwg = nM * nN; G = G_; c = c_;
        if (rev_ && nwg == 2 * G_) { c = c_ + G_; G = -G_; } }
    __host__ __device__ __forceinline__ bool next(int i, Unit& u) const {
        const int L = i * G + c; if (L >= nwg || L < 0) return false;
        int wgid = (int)L; { const int q = nwg / NXCD, r = nwg % NXCD, xcd = wgid % NXCD, off = wgid / NXCD; wgid = (xcd < r ? xcd * (q + 1) : r * (q + 1) + (xcd - r) * q) + off; }
        const int nig = WGM * nN, gid = wgid / nig, fm = gid * WGM, gsz = (nM - fm) < WGM ? (nM - fm) : WGM;
        u.pm = fm + ((wgid % nig) % gsz); u.pn = (wgid % nig) / gsz; return true;
    }
};

template <class Epi>
__device__ __forceinline__ void gemm_phase(LAS unsigned char* lds, const Gemm g, const StaticOrder& S, const Epi& E, int wid) {
    const int lane = lane_id(), tid = wid * 64 + lane, wr = wid >> 2, wc = wid & 3, fr = lane & 15, fq = lane >> 4;
    const int K = g.K, nt = K / BK, lda = g.lda;
    unsigned voffA[2], voffB[2];
#pragma unroll
    for (int i = 0; i < 2; ++i) { int R, C; stage_rc(tid * 16 + i * 8192, R, C); const int Rb = (R & ~31) + perm32(R & 31);
        voffA[i] = (unsigned)(R * lda + C) * 2u; voffB[i] = (unsigned)(Rb * K + C) * 2u; }
    const size_t kstep = (size_t)(BK * 2);
    const size_t hstepA = (size_t)HALF * lda * 2, hstepB = (size_t)HALF * K * 2;
    const size_t tstepA = 2 * hstepA, tstepB = 2 * hstepB;
    const size_t acolb = (size_t)g.acol * 2;
    const unsigned ldsw = (unsigned)wid * 1024u;
    const int aoff = lds_byte(wr * 64 + fr, fq * 8), boff = lds_byte(wc * 32 + fr, fq * 8);
#define PG8_SA(b, h) (((b) * 2 + (h)) * HTB)
#define PG8_SB(b, h) ((4 + (b) * 2 + (h)) * HTB)
#define PG8_STAGE(bufoff, gbase, voff) do { _Pragma("unroll") for (int _i = 0; _i < 2; ++_i) \
        __builtin_amdgcn_global_load_lds((const unsigned*)((const char*)(gbase) + (voff)[_i]), (LAS unsigned*)(lds + (bufoff) + ldsw + _i * 8192), 16, 0, 0); } while (0)
#define PG8_LDA(dst, b, h) do { _Pragma("unroll") for (int m = 0; m < 4; ++m) _Pragma("unroll") for (int k = 0; k < 2; ++k) dst[m][k] = *(const LAS bf16x8*)(lds + PG8_SA(b, h) + aoff + m * 2048 + k * 1024); } while (0)
#define PG8_LDB(dst, b, h) do { _Pragma("unroll") for (int n = 0; n < 2; ++n) _Pragma("unroll") for (int k = 0; k < 2; ++k) dst[n][k] = *(const LAS bf16x8*)(lds + PG8_SB(b, h) + boff + n * 2048 + k * 1024); } while (0)
#define PG8_MMA(ai, bj, At, Bt) do { __builtin_amdgcn_s_setprio(1); _Pragma("unroll") for (int m = 0; m < 4; ++m) _Pragma("unroll") for (int n = 0; n < 2; ++n) _Pragma("unroll") for (int k = 0; k < 2; ++k) \
        acc[ai][bj][m][n] = __builtin_amdgcn_mfma_f32_16x16x32_bf16(Bt[n][k], At[m][k], acc[ai][bj][m][n], 0, 0, 0); __builtin_amdgcn_s_setprio(0); } while (0)
#define PG8_WAIT_V(n) asm volatile("s_waitcnt vmcnt(" #n ")" ::: "memory")
#define PG8_WAIT_L(n) asm volatile("s_waitcnt lgkmcnt(" #n ")" ::: "memory")
#define PG8_BAR __builtin_amdgcn_s_barrier()
#define PG8_SCHED __builtin_amdgcn_sched_barrier(0)
    Unit cur, nxt; int ui = 0;
    if (!S.next(0, cur)) return;
    f32x4 acc[2][2][4][2];
#pragma unroll
    for (int a = 0; a < 2; ++a)
#pragma unroll
        for (int b = 0; b < 2; ++b)
#pragma unroll
            for (int m = 0; m < 4; ++m)
#pragma unroll
                for (int n = 0; n < 2; ++n) acc[a][b][m][n] = (f32x4){0.f, 0.f, 0.f, 0.f};
    bf16x8 At[4][2], B0[2][2], B1[2][2];
    const char* cA = (const char*)g.A + (size_t)cur.pm * tstepA + (size_t)cur.pn * acolb; const char* cB = (const char*)g.Bt + (size_t)cur.pn * tstepB;
    PG8_STAGE(PG8_SB(0, 0), cB, voffB); PG8_STAGE(PG8_SB(0, 1), cB + hstepB, voffB); PG8_STAGE(PG8_SA(0, 0), cA, voffA); PG8_STAGE(PG8_SA(0, 1), cA + hstepA, voffA);
    if (wr == 1) PG8_BAR;
    PG8_WAIT_V(2); PG8_BAR;
    PG8_STAGE(PG8_SB(1, 0), cB + kstep, voffB); PG8_STAGE(PG8_SA(1, 0), cA + kstep, voffA); PG8_STAGE(PG8_SB(1, 1), cB + hstepB + kstep, voffB);
    PG8_WAIT_V(6); PG8_BAR;
    for (;;) {
        const bool has_next = S.next(ui + 1, nxt);
        const char* nA = has_next ? (const char*)g.A + (size_t)nxt.pm * tstepA + (size_t)nxt.pn * acolb : cA; const char* nB = has_next ? (const char*)g.Bt + (size_t)nxt.pn * tstepB : cB;
#pragma nounroll
        for (int t = 0; t < nt; t += 2) {
            const bool last = (t == nt - 2);
            const char* a1 = cA + (size_t)(t + 1) * kstep;
            const char* a2 = last ? nA : cA + (size_t)(t + 2) * kstep; const char* b2 = last ? nB : cB + (size_t)(t + 2) * kstep;
            const char* a3 = a2 + kstep; const char* b3 = b2 + kstep;
            PG8_LDB(B0, 0, 0); PG8_LDB(B1, 0, 1); PG8_SCHED; PG8_LDA(At, 0, 0); PG8_STAGE(PG8_SA(1, 1), a1 + hstepA, voffA);
            PG8_WAIT_V(8); PG8_WAIT_L(0); PG8_BAR; PG8_MMA(0, 0, At, B0); PG8_MMA(0, 1, At, B1); PG8_BAR; PG8_SCHED;
            PG8_LDA(At, 0, 1); PG8_STAGE(PG8_SB(0, 0), b2, voffB); PG8_STAGE(PG8_SB(0, 1), b2 + hstepB, voffB); PG8_STAGE(PG8_SA(0, 0), a2, voffA);
            PG8_WAIT_V(8); PG8_WAIT_L(0); PG8_BAR; PG8_MMA(1, 0, At, B0); PG8_MMA(1, 1, At, B1); PG8_BAR; PG8_SCHED;
            PG8_LDB(B0, 1, 0); PG8_LDB(B1, 1, 1); PG8_SCHED; PG8_LDA(At, 1, 0); PG8_STAGE(PG8_SA(0, 1), a2 + hstepA, voffA);
            PG8_WAIT_V(8); PG8_WAIT_L(0); PG8_BAR; PG8_MMA(0, 0, At, B0); PG8_MMA(0, 1, At, B1); PG8_BAR; PG8_SCHED;
            PG8_LDA(At, 1, 1); PG8_STAGE(PG8_SB(1, 0), b3, voffB); PG8_STAGE(PG8_SB(1, 1), b3 + hstepB, voffB); PG8_STAGE(PG8_SA(1, 0), a3, voffA);
            PG8_WAIT_V(8); PG8_WAIT_L(0); PG8_BAR; PG8_MMA(1, 0, At, B0); PG8_MMA(1, 1, At, B1); PG8_BAR; PG8_SCHED;
        }
        if (wr == 0) PG8_BAR;
        E(acc, cur, wr, wc, fr, fq);
        if (!has_next) break;
#pragma unroll
        for (int a = 0; a < 2; ++a)
#pragma unroll
            for (int b = 0; b < 2; ++b)
#pragma unroll
                for (int m = 0; m < 4; ++m)
#pragma unroll
                    for (int n = 0; n < 2; ++n) acc[a][b][m][n] = (f32x4){0.f, 0.f, 0.f, 0.f};
        cur = nxt; cA = nA; cB = nB; ++ui;
        if (wr == 1) PG8_BAR;
    }
    PG8_WAIT_V(0);
    PG8_BAR;
#undef PG8_SA
#undef PG8_SB
#undef PG8_STAGE
#undef PG8_LDA
#undef PG8_LDB
#undef PG8_MMA
#undef PG8_WAIT_V
#undef PG8_WAIT_L
#undef PG8_BAR
#undef PG8_SCHED
}

struct EpiSwiglu {
    bf16_t* O; const float* bias; const float* ssq;
    __device__ __forceinline__ void operator()(const f32x4 (&acc)[2][2][4][2], const Unit& u, int wr, int wc, int fr_, int fq_) const {
        int fr = fr_, fq = fq_; asm volatile("" : "+v"(fr), "+v"(fq));
        const int b = u.pm >= (T / BM) ? 1 : 0;
        const float* bp = bias + b * NIN + u.pn * 256 + wc * 32 + 8 * fq;
        const f32x4 bg0 = *(const f32x4*)bp, bg1 = *(const f32x4*)(bp + 4), bu0 = *(const f32x4*)(bp + 128), bu1 = *(const f32x4*)(bp + 132);
        f32x4 sq[2][4];
#pragma unroll
        for (int ai = 0; ai < 2; ++ai)
#pragma unroll
            for (int m = 0; m < 4; ++m) sq[ai][m] = *(const f32x4*)(ssq + (size_t)(u.pm * BM + ai * HALF + wr * 64 + m * 16 + fr) * 4);
#pragma unroll
        for (int ai = 0; ai < 2; ++ai)
#pragma unroll
            for (int m = 0; m < 4; ++m) {
                const int row = u.pm * BM + ai * HALF + wr * 64 + m * 16 + fr;
                const float rs = rstd_from(sq[ai][m]);
                const f32x4 g0 = acc[ai][0][m][0] * rs + bg0, g1 = acc[ai][0][m][1] * rs + bg1, u0 = acc[ai][1][m][0] * rs + bu0, u1 = acc[ai][1][m][1] * rs + bu1;
                const f32x4 a0 = g0 * -1.4426950408889634f, a1 = g1 * -1.4426950408889634f;
                f32x4 e0, e1;
#pragma unroll
                for (int i = 0; i < 4; ++i) { e0[i] = __builtin_amdgcn_exp2f(a0[i]); e1[i] = __builtin_amdgcn_exp2f(a1[i]); }
                e0 = e0 + 1.0f; e1 = e1 + 1.0f;
                f32x4 r0, r1;
#pragma unroll
                for (int i = 0; i < 4; ++i) { r0[i] = __builtin_amdgcn_rcpf(e0[i]); r1[i] = __builtin_amdgcn_rcpf(e1[i]); }
                const f32x4 o0 = (g0 * u0) * r0, o1 = (g1 * u1) * r1;
                u32x4 w;
                w.x = cvtpk(o0[0], o0[1]); w.y = cvtpk(o0[2], o0[3]); w.z = cvtpk(o1[0], o1[1]); w.w = cvtpk(o1[2], o1[3]);
                __builtin_nontemporal_store(w, (u32x4*)(O + (size_t)row * FF + u.pn * 128 + wc * 32 + 8 * fq));
            }
    }
};
template <bool IN16, bool OUT16>
struct EpiResid {
    const void* xin; void* xout; const float* gc; bf16_t* xb1; const float* wk1; bf16_t* xb2; const float* wk2; float* ssq; LAS float* red;
    __device__ __forceinline__ void operator()(const f32x4 (&acc)[2][2][4][2], const Unit& u, int wr, int wc, int fr_, int fq_) const {
        int fr = fr_, fq = fq_; asm volatile("" : "+v"(fr), "+v"(fq));
        const int b = u.pm >= (T / BM) ? 1 : 0;
        const int col0 = u.pn * 256 + wc * 32 + 8 * fq;
        f32x4 gv[2][2];
#pragma unroll
        for (int bj = 0; bj < 2; ++bj) { gv[bj][0] = *(const f32x4*)(gc + b * D + col0 + bj * HALF); gv[bj][1] = *(const f32x4*)(gc + b * D + col0 + bj * HALF + 4); }
#pragma unroll
        for (int ai = 0; ai < 2; ++ai)
#pragma unroll
            for (int mp = 0; mp < 4; mp += 2) {
                f32x4 xr[2][2][2]; u32x4 xh[2][2];
#pragma unroll
                for (int mm = 0; mm < 2; ++mm)
#pragma unroll
                    for (int bj = 0; bj < 2; ++bj) { const size_t off = (size_t)(u.pm * BM + ai * HALF + wr * 64 + (mp + mm) * 16 + fr) * D + col0 + bj * HALF;
                        if (IN16) xh[mm][bj] = *(const u32x4*)((const bf16_t*)xin + off);
                        else { xr[mm][bj][0] = *(const f32x4*)((const float*)xin + off); xr[mm][bj][1] = *(const f32x4*)((const float*)xin + off + 4); } }
#pragma unroll
                for (int mm = 0; mm < 2; ++mm) {
                    const int m = mp + mm, rl = ai * HALF + wr * 64 + m * 16 + fr, row = u.pm * BM + rl;
                    float s = 0.f;
#pragma unroll
                    for (int bj = 0; bj < 2; ++bj) {
                        const size_t off = (size_t)row * D + col0 + bj * HALF;
                        f32x4 x0, x1;
                        if (IN16) { const u32x4 h = xh[mm][bj]; x0 = (f32x4){bflo(h.x), bfhi(h.x), bflo(h.y), bfhi(h.y)}; x1 = (f32x4){bflo(h.z), bfhi(h.z), bflo(h.w), bfhi(h.w)}; }
                        else { x0 = xr[mm][bj][0]; x1 = xr[mm][bj][1]; }
                        const f32x4 v0 = x0 + gv[bj][0] * acc[ai][bj][m][0], v1 = x1 + gv[bj][1] * acc[ai][bj][m][1];
                        if (OUT16) { u32x4 w; w.x = cvtpk(v0[0], v0[1]); w.y = cvtpk(v0[2], v0[3]); w.z = cvtpk(v1[0], v1[1]); w.w = cvtpk(v1[2], v1[3]); *(u32x4*)((bf16_t*)xout + off) = w; }
                        else { *(f32x4*)((float*)xout + off) = v0; *(f32x4*)((float*)xout + off + 4) = v1; }
                        s += (v0[0] * v0[0] + v0[1] * v0[1]) + (v0[2] * v0[2] + v0[3] * v0[3]) + (v1[0] * v1[0] + v1[1] * v1[1]) + (v1[2] * v1[2] + v1[3] * v1[3]);
                        if (xb1) { const float* wp = wk1 + b * D + col0 + bj * HALF; const f32x4 w0 = *(const f32x4*)wp, w1 = *(const f32x4*)(wp + 4);
                            u32x4 w; w.x = cvtpk(v0[0] * w0[0], v0[1] * w0[1]); w.y = cvtpk(v0[2] * w0[2], v0[3] * w0[3]); w.z = cvtpk(v1[0] * w1[0], v1[1] * w1[1]); w.w = cvtpk(v1[2] * w1[2], v1[3] * w1[3]);
                            *(u32x4*)(xb1 + off) = w; }
                        if (xb2) { const float* wp = wk2 + b * D + col0 + bj * HALF; const f32x4 w0 = *(const f32x4*)wp, w1 = *(const f32x4*)(wp + 4);
                            u32x4 w; w.x = cvtpk(v0[0] * w0[0], v0[1] * w0[1]); w.y = cvtpk(v0[2] * w0[2], v0[3] * w0[3]); w.z = cvtpk(v1[0] * w1[0], v1[1] * w1[1]); w.w = cvtpk(v1[2] * w1[2], v1[3] * w1[3]);
                            *(u32x4*)(xb2 + off) = w; }
                    }
                    if (ssq) { s += __shfl_xor(s, 16); s += __shfl_xor(s, 32); if (fq == 0) red[rl * 4 + wc] = s; }
                }
                asm volatile("" ::: "memory");
            }
        if (ssq) {
            asm volatile("s_waitcnt lgkmcnt(0)" ::: "memory"); __builtin_amdgcn_s_barrier(); asm volatile("" ::: "memory");
            const int tid = (wr * 4 + wc) * 64 + fq * 16 + fr;
            if (tid < 256) { const f32x4 p = *(const LAS f32x4*)(red + tid * 4); ssq[(size_t)(u.pm * BM + tid) * 4 + u.pn] = (p[0] + p[1]) + (p[2] + p[3]); }
            asm volatile("s_waitcnt lgkmcnt(0)" ::: "memory"); __builtin_amdgcn_s_barrier(); asm volatile("" ::: "memory");
        }
    }
};
struct EpiProj {
    const float* bias; int N; const float* ssq; bf16_t* dstH; bf16_t* dstVT;
    __device__ __forceinline__ void operator()(const f32x4 (&acc)[2][2][4][2], const Unit& u, int wr, int wc, int fr_, int fq_) const {
        int fr = fr_, fq = fq_; asm volatile("" : "+v"(fr), "+v"(fq));
        const int b = u.pm >= (T / BM) ? 1 : 0, blk = u.pm & (NBLK - 1);
        float rs[2][4];
#pragma unroll
        for (int ai = 0; ai < 2; ++ai)
#pragma unroll
            for (int m = 0; m < 4; ++m) rs[ai][m] = rstd_of(ssq + (size_t)(u.pm * BM + ai * HALF + wr * 64 + m * 16 + fr) * 4);
        const float* bp = bias + b * N + u.pn * 256 + wc * 32 + 8 * fq;
        if (u.pn < 4) {
#pragma unroll
            for (int bj = 0; bj < 2; ++bj) {
                f32x4 bv[2][2]; bv[bj][0] = *(const f32x4*)(bp + bj * HALF); bv[bj][1] = *(const f32x4*)(bp + bj * HALF + 4);
                const int h = 2 * u.pn + bj;
                bf16_t* hb = dstH + ((size_t)(b * NH + h) * T + blk * BS) * HD + wc * 32 + 8 * fq;
#pragma unroll
                for (int ai = 0; ai < 2; ++ai)
#pragma unroll
                    for (int m = 0; m < 4; ++m) {
                        const f32x4 v0 = acc[ai][bj][m][0] * rs[ai][m] + bv[bj][0], v1 = acc[ai][bj][m][1] * rs[ai][m] + bv[bj][1];
                        u32x4 w; w.x = cvtpk(v0[0], v0[1]); w.y = cvtpk(v0[2], v0[3]); w.z = cvtpk(v1[0], v1[1]); w.w = cvtpk(v1[2], v1[3]);
                        *(u32x4*)(hb + (unsigned)((ai * HALF + wr * 64 + m * 16 + fr) * HD)) = w;
                        asm volatile("" ::: "memory");
                    }
            }
        } else {
            const int pc = 16 * wr + fr;
#pragma unroll
            for (int bj = 0; bj < 2; ++bj) {
                f32x4 bv[2][2]; bv[bj][0] = *(const f32x4*)(bp + bj * HALF); bv[bj][1] = *(const f32x4*)(bp + bj * HALF + 4);
                const int h = 2 * (u.pn - 4) + bj;
                bf16_t* vb = dstVT + ((size_t)(b * NH + h) * NBLK + blk) * (HD * BS);
#pragma unroll
                for (int n = 0; n < 2; ++n)
#pragma unroll
                    for (int i = 0; i < 4; ++i) {
                        const int d = wc * 32 + 8 * fq + 4 * n + i;
                        const float bb = bv[bj][n][i];
                        u32x4 w;
                        w.x = cvtpk(acc[0][bj][0][n][i] * rs[0][0] + bb, acc[0][bj][1][n][i] * rs[0][1] + bb);
                        w.y = cvtpk(acc[0][bj][2][n][i] * rs[0][2] + bb, acc[0][bj][3][n][i] * rs[0][3] + bb);
                        w.z = cvtpk(acc[1][bj][0][n][i] * rs[1][0] + bb, acc[1][bj][1][n][i] * rs[1][1] + bb);
                        w.w = cvtpk(acc[1][bj][2][n][i] * rs[1][2] + bb, acc[1][bj][3][n][i] * rs[1][3] + bb);
                        *(u32x4*)(vb + (unsigned)(d * BS + ((pc ^ (d & 15)) << 3))) = w;
                        asm volatile("" ::: "memory");
                    }
            }
        }
    }
};
}

struct Args { const float* in[17]; float* out; unsigned char* ws; int ph_lo, ph_hi; };

struct Frame {
    LAS unsigned char* lds;
    int wave, G, bid;
    unsigned char* ws;
};
#define FTID const int f_lane = lane_id(); const int f_tid = F.wave * 64 + f_lane; (void)f_tid

__device__ __forceinline__ void transpose_item(const float* W, int K, int N, bf16_t* WT, bool winperm, LAS float* scr, int item, int lane) {
    const int nblk = N / 32, kb = item / nblk, nb = item % nblk, k0 = 64 * kb, n0 = 32 * nb;
    float tv[32];
#pragma unroll
    for (int i = 0; i < 32; ++i) tv[i] = W[(size_t)(k0 + 2 * i + (lane >> 5)) * N + n0 + (lane & 31)];
#pragma unroll
    for (int i = 0; i < 32; ++i) scr[(2 * i + (lane >> 5)) * 33 + (lane & 31)] = tv[i];
    asm volatile("s_waitcnt lgkmcnt(0)" ::: "memory");
    int r0 = n0;
    if (winperm) { const int bj = n0 / FF, j = n0 % FF; r0 = 256 * (j / 128) + 128 * bj + (j % 128); }
    const int c = lane & 7;
#pragma unroll
    for (int j = 0; j < 4; ++j) { const int n = (lane >> 3) + 8 * j; const LAS float* s = scr + (8 * c) * 33 + n;
        u32x4 o; o.x = cvtpk(s[0 * 33], s[1 * 33]); o.y = cvtpk(s[2 * 33], s[3 * 33]); o.z = cvtpk(s[4 * 33], s[5 * 33]); o.w = cvtpk(s[6 * 33], s[7 * 33]);
        *(u32x4*)(WT + (size_t)(r0 + n) * K + k0 + 8 * c) = o; }
    asm volatile("s_waitcnt lgkmcnt(0)" ::: "memory");
}

__device__ __forceinline__ void phase0(Frame& F, const Args& a) {
    FTID;
    const int gw = F.bid * NWAVES + F.wave, NGW = F.G * NWAVES;
    {
        LAS float* scr = (LAS float*)(F.lds + F.wave * 8448);
        constexpr int I_IN = (D / 64) * (NIN / 32), I_OUT = (FF / 64) * (D / 32), I_KV = (D / 64) * (2 * D / 32), I_Q = (D / 64) * (D / 32), I_P = (256 / 64) * (256 / 32);
        constexpr int NITEMS = 4 * I_IN + 4 * I_OUT + I_KV + 2 * I_Q + 4 * I_P;
        const float* w_in = a.in[5]; const float* w_out = a.in[6]; const float* pool_w = a.in[7]; const float* w_kv = a.in[12]; const float* w_q = a.in[14]; const float* w_o = a.in[16];
        bf16_t* WIN = (bf16_t*)(F.ws + WS_WIN); bf16_t* WOUT = (bf16_t*)(F.ws + WS_WOUT); bf16_t* WKV = (bf16_t*)(F.ws + WS_WKV); bf16_t* WQ = (bf16_t*)(F.ws + WS_WQ); bf16_t* WO = (bf16_t*)(F.ws + WS_WO); bf16_t* WP = (bf16_t*)(F.ws + WS_WPOOL);
        for (int it = gw; it < NITEMS; it += NGW) {
            int r = it;
            if (r < 4 * I_IN) { const int f = r / I_IN; transpose_item(w_in + (size_t)f * D * NIN, D, NIN, WIN + (size_t)f * NIN * D, true, scr, r % I_IN, f_lane); continue; } r -= 4 * I_IN;
            if (r < 4 * I_OUT) { const int f = r / I_OUT; transpose_item(w_out + (size_t)f * FF * D, FF, D, WOUT + (size_t)f * D * FF, false, scr, r % I_OUT, f_lane); continue; } r -= 4 * I_OUT;
            if (r < I_KV) { transpose_item(w_kv, D, 2 * D, WKV, false, scr, r, f_lane); continue; } r -= I_KV;
            if (r < I_Q) { transpose_item(w_q, D, D, WQ, false, scr, r, f_lane); continue; } r -= I_Q;
            if (r < I_Q) { transpose_item(w_o, D, D, WO, false, scr, r, f_lane); continue; } r -= I_Q;
            { const int gi = r / I_P; transpose_item(pool_w + (size_t)gi * 65536, 256, 256, WP + (size_t)gi * 65536, false, scr, r % I_P, f_lane); }
        }
    }
    __syncthreads();
    {
        LAS float* cs = (LAS float*)(F.lds + 81920);
        const float* c = a.in[1];
        for (int i = f_tid; i < 2 * D; i += 512) { const float v = c[i]; cs[i] = v / (1.0f + __expf(-v)); }
        __syncthreads();
        const float* ada_w = a.in[2]; const float* kv_ada_w = a.in[10];
        float* MODP = (float*)(F.ws + WS_MODP);
        constexpr int NCC = NMODCOL / 512;
        for (int un = F.bid; un < NCC * KSPLIT; un += F.G) {
            const int cc = un % NCC, ks = un / NCC, n = cc * 512 + f_tid;
            const float* wp; int ldw;
            if (n < 9 * D) { wp = ada_w + n; ldw = 9 * D; } else if (n < 18 * D) { wp = ada_w + (size_t)D * 9 * D + (n - 9 * D); ldw = 9 * D; } else { wp = kv_ada_w + (n - 18 * D); ldw = 2 * D; }
            float a0 = 0.f, a1 = 0.f;
            const int k0 = ks * (D / KSPLIT);
#pragma unroll 32
            for (int k = 0; k < D / KSPLIT; ++k) { const float w = wp[(size_t)(k0 + k) * ldw]; a0 += cs[k0 + k] * w; a1 += cs[D + k0 + k] * w; }
            MODP[(size_t)(ks * 2 + 0) * NMODCOL + n] = a0; MODP[(size_t)(ks * 2 + 1) * NMODCOL + n] = a1;
        }
    }
    {
        f32x2_t* ROPE = (f32x2_t*)(F.ws + WS_ROPE);
        for (int idx = F.bid * 512 + f_tid; idx < T * 64; idx += F.G * 512) {
            const int pos = idx >> 6, i = idx & 63;
            double inv = 1.0, rr = 0.8659643233600653;
#pragma unroll
            for (int k = 0; k < 6; ++k) { if ((i >> k) & 1) inv *= rr; rr *= rr; }
            const double th2 = inv * inv; double cc = 1.0, ss = 1.0;
#pragma unroll
            for (int k = 11; k >= 1; --k) { cc = 1.0 - th2 * (1.0 / (double)((2 * k - 1) * (2 * k))) * cc; ss = 1.0 - th2 * (1.0 / (double)((2 * k) * (2 * k + 1))) * ss; }
            double ck = cc, sk = inv * ss, C = 1.0, S = 0.0;
#pragma unroll
            for (int k = 0; k < 14; ++k) { if ((pos >> k) & 1) { const double nc = C * ck - S * sk, ns = S * ck + C * sk; C = nc; S = ns; } const double c2 = ck * ck - sk * sk, s2 = 2.0 * sk * ck; ck = c2; sk = s2; }
            ROPE[idx] = (f32x2_t){(float)C, (float)S};
        }
    }
}

__device__ __forceinline__ void phase1(Frame& F, const Args& a) {
    FTID;
    const float* MODP = (const float*)(F.ws + WS_MODP); float* VEC = (float*)(F.ws + WS_VEC);
    const float* ada_b = a.in[3]; const float* norm_g = a.in[4]; const float* pool_scale = a.in[8]; const float* kv_norm = a.in[9]; const float* kv_ada_b = a.in[11];
    for (int gi = F.bid * 512 + f_tid; gi < 2 * NMODCOL; gi += F.G * 512) {
        const int b = gi / NMODCOL, n = gi % NMODCOL;
        float v = 0.f;
#pragma unroll
        for (int ks = 0; ks < KSPLIT; ++ks) v += MODP[(size_t)(ks * 2 + b) * NMODCOL + n];
        if (n < 18 * D) {
            const int l = n / (9 * D), nn = n % (9 * D), ch = nn / D, k = nn % D, s = ch / 3, role = ch % 3, sub = 3 * l + s;
            v += ada_b[l * 9 * D + nn];
            if (role == 0) VEC[((1 * 7 + sub) * 2 + b) * D + k] = v;
            else if (role == 1) VEC[((0 * 7 + sub) * 2 + b) * D + k] = norm_g[(l * 3 + s) * D + k] * (1.0f + v);
            else VEC[((2 * 7 + sub) * 2 + b) * D + k] = (s == 1 ? 1.0f : 0.5f) * (1.0f + v) * (sub == 1 ? pool_scale[k] : 1.0f);
        } else {
            const int nn = n - 18 * D; v += kv_ada_b[nn];
            if (nn < D) VEC[((1 * 7 + 6) * 2 + b) * D + nn] = v; else VEC[((0 * 7 + 6) * 2 + b) * D + (nn - D)] = kv_norm[nn - D] * (1.0f + v);
        }
    }
    if (F.bid == 0 && f_tid == 0) {
        const float* kn = a.in[13]; const float* qn = a.in[15]; float mq = 0.f, mk = 0.f;
        for (int i = 0; i < HD; ++i) { mq = fmaxf(mq, fabsf(qn[i])); mk = fmaxf(mk, fabsf(kn[i])); }
        *(float*)(F.ws + WS_CREF) = 11.313708498984761f * mq * mk * 1.4426950408889634f;
    }
}

__device__ __forceinline__ void phase2(Frame& F, const Args& a) {
    FTID;
    const int gw = F.bid * NWAVES + F.wave, NGW = F.G * NWAVES;
    const float* VEC = (const float*)(F.ws + WS_VEC); float* BIAS = (float*)(F.ws + WS_BIAS);
    constexpr int NROWS = 4 * NIN + 2 * D + D;
    for (int r = 4 * gw; r < NROWS; r += 4 * NGW) {
        const bf16_t* wrow; int sub; float* o0; float* o1;
        if (r < 4 * NIN) { const int f = r / NIN, n = r % NIN; wrow = (const bf16_t*)(F.ws + WS_WIN) + ((size_t)f * NIN + n) * D; sub = (f == 0) ? 0 : (f == 1) ? 2 : (f == 2) ? 3 : 5; o0 = BIAS + (f * 2 + 0) * NIN + n; o1 = BIAS + (f * 2 + 1) * NIN + n; }
        else if (r < 4 * NIN + 2 * D) { const int n = r - 4 * NIN; wrow = (const bf16_t*)(F.ws + WS_WKV) + (size_t)n * D; sub = 6; o0 = BIAS + 8 * NIN + n; o1 = BIAS + 8 * NIN + 2 * D + n; }
        else { const int n = r - 4 * NIN - 2 * D; wrow = (const bf16_t*)(F.ws + WS_WQ) + (size_t)n * D; sub = 4; o0 = BIAS + 8 * NIN + 4 * D + n; o1 = BIAS + 8 * NIN + 4 * D + D + n; }
        u32x4 w0[4], w1[4];
#pragma unroll
        for (int q = 0; q < 4; ++q) { w0[q] = *(const u32x4*)(wrow + (size_t)q * D + f_lane * 16); w1[q] = *(const u32x4*)(wrow + (size_t)q * D + f_lane * 16 + 8); }
        const float* s0 = VEC + ((1 * 7 + sub) * 2 + 0) * D + f_lane * 16; const float* s1 = s0 + D;
        f32x4 p[4], q4[4];
#pragma unroll
        for (int j = 0; j < 4; ++j) { p[j] = *(const f32x4*)(s0 + 4 * j); q4[j] = *(const f32x4*)(s1 + 4 * j); }
        float a0[4], a1[4];
#pragma unroll
        for (int q = 0; q < 4; ++q) {
            float wv[16];
            wv[0] = bflo(w0[q].x); wv[1] = bfhi(w0[q].x); wv[2] = bflo(w0[q].y); wv[3] = bfhi(w0[q].y); wv[4] = bflo(w0[q].z); wv[5] = bfhi(w0[q].z); wv[6] = bflo(w0[q].w); wv[7] = bfhi(w0[q].w);
            wv[8] = bflo(w1[q].x); wv[9] = bfhi(w1[q].x); wv[10] = bflo(w1[q].y); wv[11] = bfhi(w1[q].y); wv[12] = bflo(w1[q].z); wv[13] = bfhi(w1[q].z); wv[14] = bflo(w1[q].w); wv[15] = bfhi(w1[q].w);
            float x0 = 0.f, x1 = 0.f;
#pragma unroll
            for (int j = 0; j < 4; ++j)
#pragma unroll
                for (int e = 0; e < 4; ++e) { x0 += p[j][e] * wv[4 * j + e]; x1 += q4[j][e] * wv[4 * j + e]; }
            a0[q] = x0; a1[q] = x1;
        }
#pragma unroll
        for (int o = 1; o < 64; o <<= 1) {
#pragma unroll
            for (int q = 0; q < 4; ++q) { a0[q] += __shfl_xor(a0[q], o); a1[q] += __shfl_xor(a1[q], o); } }
        if (f_lane == 0) {
#pragma unroll
            for (int q = 0; q < 4; ++q) { o0[q] = a0[q]; o1[q] = a1[q]; } }
    }
    const float* x = a.in[0]; bf16_t* XB = (bf16_t*)(F.ws + WS_XB); float* SSQ = (float*)(F.ws + WS_SSQA);
#pragma unroll 2
    for (int m = gw; m < M; m += NGW) {
        const int b = m >= T ? 1 : 0;
        const f32x4* xr = (const f32x4*)(x + (size_t)m * D) + f_lane; const f32x4* wk = (const f32x4*)(VEC + ((0 * 7 + 0) * 2 + b) * D) + f_lane;
        f32x4 v[4]; float s = 0.f;
#pragma unroll
        for (int j = 0; j < 4; ++j) { v[j] = xr[64 * j]; s += (v[j][0] * v[j][0] + v[j][1] * v[j][1]) + (v[j][2] * v[j][2] + v[j][3] * v[j][3]); }
        s = wave_sum(s);
        u32x2* o8 = (u32x2*)(XB + (size_t)m * D) + f_lane;
#pragma unroll
        for (int j = 0; j < 4; ++j) { const f32x4 w = wk[64 * j]; u32x2 o; o.x = cvtpk(v[j][0] * w[0], v[j][1] * w[1]); o.y = cvtpk(v[j][2] * w[2], v[j][3] * w[3]); o8[64 * j] = o; }
        if (f_lane < 4) SSQ[(size_t)m * 4 + f_lane] = (f_lane == 0) ? s : 0.f;
    }
}

__device__ __forceinline__ void phase_pool_elem(Frame& F, const bf16_t* x, const float* ssq) {
    FTID;
    const float* VEC = (const float*)(F.ws + WS_VEC); bf16_t* OUT = (bf16_t*)(F.ws + WS_XB2);
    LAS float* rsl = (LAS float*)F.lds;
    const int gi = F.wave >> 1, w = 2 << gi;
    const int tq = (f_tid >> 5) & 3, c = 8 * ((f_tid & 31) | (gi << 5));
    for (int un = F.bid; un < M / 64; un += F.G) {
        const int m0 = un * 64, b = m0 >= T ? 1 : 0, bstart = b * T;
        __syncthreads();
        if (f_tid < 79) { const int tok = m0 - 15 + f_tid; rsl[f_tid] = (tok >= bstart) ? rstd_of(ssq + (size_t)tok * 4) : 0.f; }
        __syncthreads();
        const f32x4 wk0 = *(const f32x4*)(VEC + ((0 * 7 + 1) * 2 + b) * D + c), wk1 = *(const f32x4*)(VEC + ((0 * 7 + 1) * 2 + b) * D + c + 4);
        const int t0 = m0 + 16 * tq;
        f32x4 sa = {0.f, 0.f, 0.f, 0.f}, sb = {0.f, 0.f, 0.f, 0.f};
#define POOL_UNPK(h_, r_, a_, b_) do { a_ = (f32x4){bflo(h_.x), bfhi(h_.x), bflo(h_.y), bfhi(h_.y)} * (r_); b_ = (f32x4){bflo(h_.z), bfhi(h_.z), bflo(h_.w), bfhi(h_.w)} * (r_); } while (0)
#pragma nounroll
        for (int sx = t0 - w + 1; sx < t0; ++sx) if (sx >= bstart) { const u32x4 h = *(const u32x4*)(x + (size_t)sx * D + c); f32x4 a, bb; POOL_UNPK(h, rsl[sx - m0 + 15], a, bb); sa += a; sb += bb; }
#pragma unroll 8
        for (int t = t0; t < t0 + 16; ++t) {
            const u32x4 h = *(const u32x4*)(x + (size_t)t * D + c); f32x4 xa, xb_; POOL_UNPK(h, rsl[t - m0 + 15], xa, xb_);
            sa += xa; sb += xb_;
            const int tb = t - bstart; const float ic = 1.0f / (float)(tb + 1 < w ? tb + 1 : w);
            const f32x4 oa = wk0 * (sa * ic - xa), ob = wk1 * (sb * ic - xb_);
            u32x4 o; o.x = cvtpk(oa[0], oa[1]); o.y = cvtpk(oa[2], oa[3]); o.z = cvtpk(ob[0], ob[1]); o.w = cvtpk(ob[2], ob[3]);
            *(u32x4*)(OUT + (size_t)t * D + c) = o;
            const int so = t - w + 1;
            if (so >= bstart) { const u32x4 ho = *(const u32x4*)(x + (size_t)so * D + c); f32x4 a, bb; POOL_UNPK(ho, rsl[so - m0 + 15], a, bb); sa -= a; sb -= bb; }
        }
#undef POOL_UNPK
    }
}

__device__ __forceinline__ int key_of_pos(int p) { return 128 * ((p & 7) >> 2) + 64 * (p >> 7) + 16 * (p & 3) + ((p >> 3) & 15); }
__device__ __forceinline__ int pos_of_krow(int R) { return (R & ~12) | ((R & 4) << 1) | ((R & 8) >> 1); }

__device__ __forceinline__ void phase_kvprep(Frame& F, const Args& a) {
    FTID;
    bf16_t* KN = (bf16_t*)(F.ws + WS_KN); float* KMEAN = (float*)(F.ws + WS_KMEAN); const f32x2_t* ROPE = (const f32x2_t*)(F.ws + WS_ROPE);
    const float* k_norm = a.in[13];
    LAS float* part = (LAS float*)F.lds;
    const int lane = f_lane, ch = lane & 15, rsub = lane >> 4;
    const f32x4 gk0 = *(const f32x4*)(k_norm + 8 * ch), gk1 = *(const f32x4*)(k_norm + 8 * ch + 4);
    const float sgn = (ch < 8) ? -1.0f : 1.0f;
    for (int it = F.bid; it < BATCH * NH * NBLK; it += F.G) {
        const int blk = it & (NBLK - 1);
        bf16_t* base = KN + (size_t)it * (BS * HD);
        u32x4 raw[8];
#pragma unroll
        for (int p = 0; p < 8; ++p) raw[p] = *(const u32x4*)(base + (size_t)(p * 32 + F.wave * 4 + rsub) * HD + 8 * ch);
        asm volatile("s_waitcnt vmcnt(0)" ::: "memory");
        __syncthreads();
        float cs8[8] = {0.f, 0.f, 0.f, 0.f, 0.f, 0.f, 0.f, 0.f};
#pragma unroll
        for (int p = 0; p < 8; ++p) {
            const int row = p * 32 + F.wave * 4 + rsub, pos = blk * BS + row;
            const f32x4* rt = (const f32x4*)(ROPE + (size_t)pos * 64 + 8 * (ch & 7));
            const f32x4 c0 = rt[0], c1 = rt[1], c2 = rt[2], c3 = rt[3];
            const u32x4 rw = raw[p];
            float x[8] = {bflo(rw.x), bfhi(rw.x), bflo(rw.y), bfhi(rw.y), bflo(rw.z), bfhi(rw.z), bflo(rw.w), bfhi(rw.w)};
            float ss = 0.f;
#pragma unroll
            for (int e = 0; e < 8; ++e) ss += x[e] * x[e];
            ss += __shfl_xor(ss, 1); ss += __shfl_xor(ss, 2); ss += __shfl_xor(ss, 4); ss += __shfl_xor(ss, 8);
            const float rs = __builtin_amdgcn_rsqf(ss * (1.0f / HD) + EPS);
            float y[8], py[8];
#pragma unroll
            for (int e = 0; e < 4; ++e) { y[e] = x[e] * rs * gk0[e]; y[4 + e] = x[4 + e] * rs * gk1[e]; }
#pragma unroll
            for (int e = 0; e < 8; ++e) py[e] = __shfl_xor(y[e], 8);
            const float cs_[8] = {c0[0], c0[2], c1[0], c1[2], c2[0], c2[2], c3[0], c3[2]}, sn_[8] = {c0[1], c0[3], c1[1], c1[3], c2[1], c2[3], c3[1], c3[3]};
            float o[8];
#pragma unroll
            for (int e = 0; e < 8; ++e) { o[e] = y[e] * cs_[e] + sgn * py[e] * sn_[e]; cs8[e] += o[e]; }
            u32x4 w; w.x = cvtpk(o[0], o[1]); w.y = cvtpk(o[2], o[3]); w.z = cvtpk(o[4], o[5]); w.w = cvtpk(o[6], o[7]);
            const int pp = 8 * (16 * ((row >> 6) & 1) + (row & 15)) + 4 * (row >> 7) + ((row >> 4) & 3);
            const int R = (pp & ~12) | ((pp & 4) << 1) | ((pp & 8) >> 1);
            *(u32x4*)(base + (size_t)R * HD + ((ch ^ (R & 15)) << 3)) = w;
        }
#pragma unroll
        for (int e = 0; e < 8; ++e) { cs8[e] += __shfl_xor(cs8[e], 16); cs8[e] += __shfl_xor(cs8[e], 32); }
        if (rsub == 0) { *(LAS f32x4*)(part + F.wave * 128 + 8 * ch) = (f32x4){cs8[0], cs8[1], cs8[2], cs8[3]}; *(LAS f32x4*)(part + F.wave * 128 + 8 * ch + 4) = (f32x4){cs8[4], cs8[5], cs8[6], cs8[7]}; }
        __syncthreads();
        if (f_tid < 128) { float sm = 0.f;
#pragma unroll
            for (int wv = 0; wv < 8; ++wv) sm += part[wv * 128 + f_tid];
            KMEAN[(size_t)it * HD + f_tid] = sm * (1.0f / BS); }
    }
    __syncthreads();
}

__device__ __forceinline__ void phase_sel(Frame& F, const Args& a) {
    FTID;
    bf16_t* QN = (bf16_t*)(F.ws + WS_QN); const float* KMEAN = (const float*)(F.ws + WS_KMEAN); const f32x2_t* ROPE = (const f32x2_t*)(F.ws + WS_ROPE);
    unsigned* CNT = (unsigned*)(F.ws + WS_CNT); unsigned short* LIST = (unsigned short*)(F.ws + WS_LIST);
    const float* q_norm = a.in[15];
    LAS unsigned char* QT = F.lds;
    LAS unsigned char* KMH = F.lds + 65536;
    LAS unsigned char* KML = F.lds + 81920;
    LAS unsigned* hist = (LAS unsigned*)(F.lds + 98304);
    const int lane = f_lane, ch = lane & 15, rsub = lane >> 4;
    const f32x4 gq0 = *(const f32x4*)(q_norm + 8 * ch), gq1 = *(const f32x4*)(q_norm + 8 * ch + 4);
    const float sgn = (ch < 8) ? -1.0f : 1.0f;
    for (int it = F.bid; it < BATCH * NH * NBLK; it += F.G) {
        const int bh = it >> 6; int n = it & 63; { const int rr = (bh >> 2) & 3; if (rr & 2) n ^= 32; if (rr & 1) n = 63 - n; }
        __syncthreads();
        if (f_tid < 64) hist[f_tid] = 0u;
#pragma unroll
        for (int k2 = 0; k2 < 2; ++k2) {
            const int cidx = f_tid + 512 * k2, j = cidx >> 4, c = cidx & 15;
            u32x4 hw = {0u, 0u, 0u, 0u}, lw = {0u, 0u, 0u, 0u};
            if (j < n) { const float* kp = KMEAN + ((size_t)bh * NBLK + j) * HD + 8 * c; const f32x4 v0 = *(const f32x4*)kp, v1 = *(const f32x4*)(kp + 4);
                hw.x = cvtpk(v0[0], v0[1]); hw.y = cvtpk(v0[2], v0[3]); hw.z = cvtpk(v1[0], v1[1]); hw.w = cvtpk(v1[2], v1[3]);
                lw.x = cvtpk(v0[0] - bflo(hw.x), v0[1] - bfhi(hw.x)); lw.y = cvtpk(v0[2] - bflo(hw.y), v0[3] - bfhi(hw.y));
                lw.z = cvtpk(v1[0] - bflo(hw.z), v1[1] - bfhi(hw.z)); lw.w = cvtpk(v1[2] - bflo(hw.w), v1[3] - bfhi(hw.w)); }
            *(LAS u32x4*)(KMH + j * 256 + ((c ^ (j & 15)) << 4)) = hw; *(LAS u32x4*)(KML + j * 256 + ((c ^ (j & 15)) << 4)) = lw;
        }
#pragma unroll 2
        for (int p = 0; p < 8; ++p) {
            const int row = p * 32 + F.wave * 4 + rsub, t = n * BS + row;
            bf16_t* rp = QN + ((size_t)bh * T + t) * HD + 8 * ch;
            const u32x4 raw = *(const u32x4*)rp;
            const f32x4* rt = (const f32x4*)(ROPE + (size_t)t * 64 + 8 * (ch & 7));
            const f32x4 c0 = rt[0], c1 = rt[1], c2 = rt[2], c3 = rt[3];
            float x[8] = {bflo(raw.x), bfhi(raw.x), bflo(raw.y), bfhi(raw.y), bflo(raw.z), bfhi(raw.z), bflo(raw.w), bfhi(raw.w)};
            float ss = 0.f;
#pragma unroll
            for (int e = 0; e < 8; ++e) ss += x[e] * x[e];
            ss += __shfl_xor(ss, 1); ss += __shfl_xor(ss, 2); ss += __shfl_xor(ss, 4); ss += __shfl_xor(ss, 8);
            const float rs = __builtin_amdgcn_rsqf(ss * (1.0f / HD) + EPS);
            float y[8], py[8];
#pragma unroll
            for (int e = 0; e < 4; ++e) { y[e] = x[e] * rs * gq0[e]; y[4 + e] = x[4 + e] * rs * gq1[e]; }
#pragma unroll
            for (int e = 0; e < 8; ++e) py[e] = __shfl_xor(y[e], 8);
            const float cs_[8] = {c0[0], c0[2], c1[0], c1[2], c2[0], c2[2], c3[0], c3[2]}, sn_[8] = {c0[1], c0[3], c1[1], c1[3], c2[1], c2[3], c3[1], c3[3]};
            float o[8];
#pragma unroll
            for (int e = 0; e < 8; ++e) o[e] = y[e] * cs_[e] + sgn * py[e] * sn_[e];
            u32x4 w; w.x = cvtpk(o[0], o[1]); w.y = cvtpk(o[2], o[3]); w.z = cvtpk(o[4], o[5]); w.w = cvtpk(o[6], o[7]);
            *(u32x4*)rp = w;
            *(LAS u32x4*)(QT + row * 256 + ((ch ^ (row & 15)) << 4)) = w;
        }
        __syncthreads();
        const int q = lane & 31, hi = lane >> 5, sw = q & 15, qrow = 32 * F.wave + q;
        bf16x8 qf[8];
#pragma unroll
        for (int d0 = 0; d0 < 8; ++d0) qf[d0] = *(const LAS bf16x8*)(QT + qrow * 256 + (((2 * d0 + hi) ^ sw) << 4));
        float g0 = -INFINITY, g1 = -INFINITY, g2 = -INFINITY; int j0 = 0, j1 = 1, j2 = 2;
#define SEL_INS(gt_, jt_) do { const float gt = (gt_); const int jt = (jt_); \
            if (gt > g0 || (gt == g0 && jt < j0)) { g2 = g1; j2 = j1; g1 = g0; j1 = j0; g0 = gt; j0 = jt; } \
            else if (gt > g1 || (gt == g1 && jt < j1)) { g2 = g1; j2 = j1; g1 = gt; j1 = jt; } \
            else if (gt > g2 || (gt == g2 && jt < j2)) { g2 = gt; j2 = jt; } } while (0)
#pragma unroll
        for (int tau = 0; tau < 2; ++tau) {
            if (32 * tau < n) {
                f32x16 sacc = {};
                const LAS unsigned char* kh = KMH + (32 * tau + q) * 256; const LAS unsigned char* kl = KML + (32 * tau + q) * 256;
#pragma unroll
                for (int d0 = 0; d0 < 8; ++d0) {
                    const bf16x8 ah = *(const LAS bf16x8*)(kh + (((2 * d0 + hi) ^ sw) << 4)), al = *(const LAS bf16x8*)(kl + (((2 * d0 + hi) ^ sw) << 4));
                    sacc = __builtin_amdgcn_mfma_f32_32x32x16_bf16(ah, qf[d0], sacc, 0, 0, 0);
                    sacc = __builtin_amdgcn_mfma_f32_32x32x16_bf16(al, qf[d0], sacc, 0, 0, 0);
                }
#pragma unroll
                for (int r = 0; r < 16; ++r) { const int jb = 32 * tau + (r & 3) + 8 * (r >> 2) + 4 * hi; if (jb < n) SEL_INS(sacc[r], jb); }
            }
        }
        {
            const float pg0 = __shfl_xor(g0, 32), pg1 = __shfl_xor(g1, 32), pg2 = __shfl_xor(g2, 32);
            const int pj0 = __shfl_xor(j0, 32), pj1 = __shfl_xor(j1, 32), pj2 = __shfl_xor(j2, 32);
            if (pg0 > -INFINITY) SEL_INS(pg0, pj0);
            if (pg1 > -INFINITY) SEL_INS(pg1, pj1);
            if (pg2 > -INFINITY) SEL_INS(pg2, pj2);
        }
#undef SEL_INS
        const int t = n * BS + qrow;
        const int nsel = (hi == 0) ? (n < 3 ? n : 3) : 0;
        if (n < 3) { j0 = 0; j1 = 1; j2 = 2; }
        unsigned l0 = 0, l1 = 0, l2 = 0;
        if (nsel > 0) l0 = atomicAdd((unsigned*)&hist[j0], 1u);
        if (nsel > 1) l1 = atomicAdd((unsigned*)&hist[j1], 1u);
        if (nsel > 2) l2 = atomicAdd((unsigned*)&hist[j2], 1u);
        __syncthreads();
        if (f_tid < 64) { const unsigned c = hist[f_tid]; hist[64 + f_tid] = c ? atomicAdd(&CNT[bh * NBLK + f_tid], c) : 0u; }
        __syncthreads();
        unsigned short* lb = LIST + (size_t)bh * NBLK * T;
        if (nsel > 0) lb[(size_t)j0 * T + hist[64 + j0] + l0] = (unsigned short)((t << 2) | 0);
        if (nsel > 1) lb[(size_t)j1 * T + hist[64 + j1] + l1] = (unsigned short)((t << 2) | 1);
        if (nsel > 2) lb[(size_t)j2 * T + hist[64 + j2] + l2] = (unsigned short)((t << 2) | 2);
    }
    __syncthreads();
}

template <bool CAUSAL>
__device__ __forceinline__ void attn_qk(const LAS unsigned char* kl, const bf16x8 (&qf)[8], u32x4 (&pk)[8][2], float& lsum, int qrow, int lane, float c1, float c2) {
    const int i = lane & 31, hi = lane >> 5, sw = i & 15;
    int qr = qrow - hi; asm volatile("" : "+v"(qr));
#pragma unroll
    for (int tau = 0; tau < 8; ++tau) {
        f32x16 s = {};
        const LAS unsigned char* kp = kl + (32 * tau + i) * 256;
#pragma unroll
        for (int d0 = 0; d0 < 8; ++d0) { const bf16x8 kf = *(const LAS bf16x8*)(kp + (((2 * d0 + hi) ^ sw) << 4)); s = __builtin_amdgcn_mfma_f32_32x32x16_bf16(kf, qf[d0], s, 0, 0, 0); }
        float p[16];
#pragma unroll
        for (int r = 0; r < 16; ++r) {
            float e = __builtin_amdgcn_exp2f(s[r] * c1 - c2);
            if (CAUSAL) { const int keyc = 128 * ((r >> 2) & 1) + 64 * (tau >> 2) + 16 * (r & 3) + 4 * (tau & 3) + 2 * (r >> 3);
                e = __uint_as_float(__float_as_uint(e) & ~(unsigned)((qr - keyc) >> 31)); }
            p[r] = e; lsum += e;
        }
        pk[tau][0].x = cvtpk(p[0], p[1]); pk[tau][0].y = cvtpk(p[2], p[3]); pk[tau][0].z = cvtpk(p[4], p[5]); pk[tau][0].w = cvtpk(p[6], p[7]);
        pk[tau][1].x = cvtpk(p[8], p[9]); pk[tau][1].y = cvtpk(p[10], p[11]); pk[tau][1].z = cvtpk(p[12], p[13]); pk[tau][1].w = cvtpk(p[14], p[15]);
    }
}
__device__ __forceinline__ void attn_pv(const LAS unsigned char* vl, const u32x4 (&pk)[8][2], f32x16 (&o)[4], int lane) {
    const int i = lane & 31, hi = lane >> 5, sw = i & 15;
#pragma unroll
    for (int tau = 0; tau < 8; ++tau) {
        const bf16x8 pa0 = __builtin_bit_cast(bf16x8, pk[tau][0]), pa1 = __builtin_bit_cast(bf16x8, pk[tau][1]);
#pragma unroll
        for (int d0 = 0; d0 < 4; ++d0) {
            const LAS unsigned char* vp = vl + (32 * d0 + i) * 512;
            const bf16x8 v0 = *(const LAS bf16x8*)(vp + (((4 * tau + hi) ^ sw) << 4)), v1 = *(const LAS bf16x8*)(vp + (((4 * tau + 2 + hi) ^ sw) << 4));
            o[d0] = __builtin_amdgcn_mfma_f32_32x32x16_bf16(v0, pa0, o[d0], 0, 0, 0);
            o[d0] = __builtin_amdgcn_mfma_f32_32x32x16_bf16(v1, pa1, o[d0], 0, 0, 0);
        }
    }
}
__device__ __forceinline__ void dma_image(LAS unsigned char* dst, const bf16_t* src, int wave, int lane) {
#pragma unroll
    for (int i = 0; i < 8; ++i)
        __builtin_amdgcn_global_load_lds((const unsigned*)((const char*)src + ((i * 8 + wave) * 1024 + lane * 16)), (LAS unsigned*)(dst + (i * 8 + wave) * 1024), 16, 0, 0);
}
#define VM_WAIT0() asm volatile("s_waitcnt vmcnt(0)" ::: "memory")


__device__ __forceinline__ void store_rows_staged(LAS unsigned char* stg, const f32x16 (&o)[4], float scale, long rowoff, int sel, bool valid, bf16_t* base0, bf16_t* base1, bf16_t* base2, int lane) {
    const int q = lane & 31, hi = lane >> 5;
    const int lo32 = (int)(unsigned)(rowoff & 0xffffffffl), hi32 = (int)(rowoff >> 32);
    const int meta = valid ? sel : -1;
#pragma unroll
    for (int p = 0; p < 8; ++p) {
        if ((q >> 2) == p) {
            LAS unsigned char* wp = stg + (q & 3) * 272 + 8 * hi;
#pragma unroll
            for (int d0 = 0; d0 < 4; ++d0)
#pragma unroll
                for (int g = 0; g < 4; ++g) { u32x2 w; w.x = cvtpk(o[d0][4 * g] * scale, o[d0][4 * g + 1] * scale); w.y = cvtpk(o[d0][4 * g + 2] * scale, o[d0][4 * g + 3] * scale); *(LAS u32x2*)(wp + 64 * d0 + 16 * g) = w; }
        }
        asm volatile("s_waitcnt lgkmcnt(0)" ::: "memory");
        const int src = 4 * p + (lane >> 4);
        const int m_ = __shfl(meta, src), l_ = __shfl(lo32, src), h_ = __shfl(hi32, src);
        const u32x4 v = *(const LAS u32x4*)(stg + (lane >> 4) * 272 + (lane & 15) * 16);
        asm volatile("s_waitcnt lgkmcnt(0)" ::: "memory");
        if (m_ >= 0) {
            bf16_t* bp = (m_ == 0) ? base0 : (m_ == 1) ? base1 : base2;
            const long ro = ((long)h_ << 32) | (long)(unsigned)l_;
            *(u32x4*)(bp + ro + (lane & 15) * 8) = v;
        }
    }
}

template <int VAR>
__device__ __forceinline__ void phase_part1(Frame& F, int b) {
    FTID;
    const bf16_t* KN = (const bf16_t*)(F.ws + WS_KN) + (size_t)b * NH * NBLK * (BS * HD); const bf16_t* VT = (const bf16_t*)(F.ws + WS_VT) + (size_t)b * NH * NBLK * (BS * HD);
    const bf16_t* QN = (const bf16_t*)(F.ws + WS_QN) + (size_t)b * NH * T * HD;
    const unsigned* CNT = (const unsigned*)(F.ws + WS_CNT) + b * NH * NBLK; const unsigned short* LIST = (const unsigned short*)(F.ws + WS_LIST) + (size_t)b * NH * NBLK * T;
    float* LS = (float*)(F.ws + WS_LS);
    LAS int* pref = (LAS int*)(F.lds + 131072);
    LAS int* cnl = (LAS int*)(F.lds + 131072 + 2064);
    LAS int* ncs = (LAS int*)(F.lds + 131072 + 4160);
    LAS unsigned char* stg = F.lds + 131072 + 4160 + F.wave * 1088;
    const float c1 = 0.08838834764831845f * 1.4426950408889634f, c2 = *(const float*)(F.ws + WS_CREF);
    __syncthreads();
    { const unsigned c = CNT[f_tid]; cnl[f_tid] = (int)c; ncs[f_tid] = (int)((c + 255u) >> 8); }
    __syncthreads();
    { int s = 0; for (int i = 0; i < f_tid; ++i) s += ncs[i]; pref[f_tid] = s; if (f_tid == 511) pref[512] = s + ncs[511]; }
    __syncthreads();
    const int total = pref[512];
    const int lane = f_lane, q = lane & 31, hi = lane >> 5;
#define P1_FIND(it_, hj_, ch_) do { int lo_ = 0, hi2_ = 511; while (lo_ < hi2_) { const int mid_ = (lo_ + hi2_ + 1) >> 1; if (pref[mid_] <= (it_)) lo_ = mid_; else hi2_ = mid_ - 1; } hj_ = lo_; ch_ = (it_) - pref[lo_]; } while (0)
    const int vcu = ((F.G & 7) == 0) ? (F.bid & 7) * (F.G >> 3) + (F.bid >> 3) : F.bid;
    int it = (int)(((long)total * vcu) / F.G); const int it_end = (int)(((long)total * (vcu + 1)) / F.G);
    if (it >= it_end) return;
    int hj, ch; P1_FIND(it, hj, ch);
    bool newblk = true;
    dma_image(F.lds, KN + (size_t)hj * (BS * HD), F.wave, lane);
    bool valid; int t, r; bf16x8 qf[8];
    { const int li = ch * 256 + F.wave * 32 + q; valid = li < cnl[hj]; const unsigned e = valid ? LIST[(size_t)hj * T + li] : 0u; t = (int)(e >> 2); r = (int)(e & 3);
      const bf16_t* qp = QN + ((size_t)(hj >> 6) * T + t) * HD + 8 * hi;
#pragma unroll
      for (int d0 = 0; d0 < 8; ++d0) qf[d0] = *(const bf16x8*)(qp + 16 * d0); }
    for (;;) {
        const int itn = it + 1; const bool has_next = itn < it_end;
        int hjn = 0, chn = 0; if (has_next) P1_FIND(itn, hjn, chn);
        VM_WAIT0(); __syncthreads();
        if (newblk) dma_image(F.lds + 65536, VT + (size_t)hj * (BS * HD), F.wave, lane);
        bool validn = false; unsigned en = 0u;
        if (has_next) { const int li = chn * 256 + F.wave * 32 + q; validn = li < cnl[hjn]; en = validn ? LIST[(size_t)hjn * T + li] : 0u; }
        u32x4 pk[8][2]; float lsum = 0.f;
        if (VAR < 3) attn_qk<false>(F.lds, qf, pk, lsum, 0, lane, c1, c2);
        else {
#pragma unroll
            for (int a_ = 0; a_ < 8; ++a_) { pk[a_][0] = (u32x4){0u, 0u, 0u, 0u}; pk[a_][1] = (u32x4){0u, 0u, 0u, 0u}; } }
        lsum += __shfl_xor(lsum, 32);
        VM_WAIT0(); __syncthreads();
        const int tn = (int)(en >> 2), rn = (int)(en & 3);
        if (has_next) {
            if (hjn != hj) dma_image(F.lds, KN + (size_t)hjn * (BS * HD), F.wave, lane);
            const bf16_t* qp = QN + ((size_t)(hjn >> 6) * T + tn) * HD + 8 * hi;
#pragma unroll
            for (int d0 = 0; d0 < 8; ++d0) qf[d0] = *(const bf16x8*)(qp + 16 * d0);
        }
        f32x16 o[4]; o[0] = f32x16{}; o[1] = f32x16{}; o[2] = f32x16{}; o[3] = f32x16{};
        if (VAR < 2) attn_pv(F.lds + 65536, pk, o, lane);
        if (VAR < 1) {
            const int h = hj >> 6;
            store_rows_staged(stg, o, 1.0f, ((long)h * T + t) * HD, r, valid, (bf16_t*)(F.ws + WS_XB2), (bf16_t*)(F.ws + WS_XB2 + 32 * MiB), (bf16_t*)(F.ws + WS_SLOT2), lane);
            if (valid && hi == 0) LS[((size_t)r * NH + h) * T + t] = lsum;
        }
        if (!has_next) break;
        newblk = (hjn != hj);
        it = itn; hj = hjn; ch = chn; valid = validn; t = tn; r = rn;
    }
    VM_WAIT0();
    __syncthreads();
#undef P1_FIND
}

__device__ __forceinline__ void phase_part2(Frame& F, int b) {
    FTID;
    const bf16_t* KN = (const bf16_t*)(F.ws + WS_KN) + (size_t)b * NH * NBLK * (BS * HD); const bf16_t* VT = (const bf16_t*)(F.ws + WS_VT) + (size_t)b * NH * NBLK * (BS * HD);
    const bf16_t* QN = (const bf16_t*)(F.ws + WS_QN) + (size_t)b * NH * T * HD;
    const float* LS = (const float*)(F.ws + WS_LS); bf16_t* ATT = (bf16_t*)(F.ws + WS_XB);
    const float c1 = 0.08838834764831845f * 1.4426950408889634f, c2 = *(const float*)(F.ws + WS_CREF);
    const int lane = f_lane, q = lane & 31, hi = lane >> 5;
    const int qrow = F.wave * 32 + q;
    int it = F.bid;
    if (it >= NH * NBLK) return;
    __syncthreads();
    dma_image(F.lds, KN + (size_t)it * (BS * HD), F.wave, lane);
    bf16x8 qf[8];
    { const bf16_t* qp = QN + ((size_t)(it >> 6) * T + (it & 63) * BS + qrow) * HD + 8 * hi;
#pragma unroll
      for (int d0 = 0; d0 < 8; ++d0) qf[d0] = *(const bf16x8*)(qp + 16 * d0); }
    for (;;) {
        const int itn = it + F.G; const bool has_next = itn < NH * NBLK;
        const int h = it >> 6, n = it & 63, t = n * BS + qrow;
        VM_WAIT0(); __syncthreads();
        dma_image(F.lds + 65536, VT + (size_t)it * (BS * HD), F.wave, lane);
        u32x4 pk[8][2]; float lsum = 0.f;
        attn_qk<true>(F.lds, qf, pk, lsum, qrow, lane, c1, c2);
        lsum += __shfl_xor(lsum, 32);
        VM_WAIT0(); __syncthreads();
        if (has_next) {
            dma_image(F.lds, KN + (size_t)itn * (BS * HD), F.wave, lane);
            const bf16_t* qp = QN + ((size_t)(itn >> 6) * T + (itn & 63) * BS + qrow) * HD + 8 * hi;
#pragma unroll
            for (int d0 = 0; d0 < 8; ++d0) qf[d0] = *(const bf16x8*)(qp + 16 * d0);
        }
        f32x16 o[4]; o[0] = f32x16{}; o[1] = f32x16{}; o[2] = f32x16{}; o[3] = f32x16{};
        attn_pv(F.lds + 65536, pk, o, lane);
        const int nsel = n < 3 ? n : 3;
        for (int r = 0; r < nsel; ++r) {
            const bf16_t* sp = (const bf16_t*)(F.ws + (r == 2 ? WS_SLOT2 : WS_XB2 + (size_t)r * 32 * MiB)) + ((size_t)h * T + t) * HD + 4 * hi;
            const float lr = LS[((size_t)r * NH + h) * T + t];
            u32x2 sw_[4][4];
#pragma unroll
            for (int d0 = 0; d0 < 4; ++d0)
#pragma unroll
                for (int g = 0; g < 4; ++g) sw_[d0][g] = *(const u32x2*)(sp + 32 * d0 + 8 * g);
            lsum += lr;
#pragma unroll
            for (int d0 = 0; d0 < 4; ++d0)
#pragma unroll
                for (int g = 0; g < 4; ++g) { const u32x2 w = sw_[d0][g]; o[d0][4 * g] += bflo(w.x); o[d0][4 * g + 1] += bfhi(w.x); o[d0][4 * g + 2] += bflo(w.y); o[d0][4 * g + 3] += bfhi(w.y); }
        }
        const float il = 1.0f / lsum;
        store_rows_staged(F.lds + 131072 + 4160 + F.wave * 1088, o, il, ((long)(b * T + t)) * D + h * HD, 0, true, ATT, ATT, ATT, lane);
        if (!has_next) break;
        it = itn;
    }
    VM_WAIT0();
    __syncthreads();
}

#define XB_TMO      128
#define XB_XCNT(j)  (256  + 64 * (j))
#define XB_XSUB(j)  (1280 + 64 * (j))
#define XB_XGEN(j)  (2304 + 64 * (j))
#define XB_TOP      3328
#define XB_TOPGEN   3392
#define XCD_BAR_WORDS 3456
#define XB_SPIN_CAP (1u << 20)
__device__ __forceinline__ unsigned xb_ld(unsigned* p)              { return __hip_atomic_load(p, __ATOMIC_RELAXED, __HIP_MEMORY_SCOPE_AGENT); }
__device__ __forceinline__ unsigned xb_add(unsigned* p, unsigned v) { return __hip_atomic_fetch_add(p, v, __ATOMIC_RELAXED, __HIP_MEMORY_SCOPE_AGENT); }
__device__ __forceinline__ unsigned xb_xcc_id() { return (unsigned)__builtin_amdgcn_s_getreg((3 << 11) | 20) & 0xFu; }
#define XB_SPIN(cond, bar) do { unsigned _sp = 0; while (cond) { __builtin_amdgcn_s_sleep(1); \
    if ((++_sp & 255u) == 0u) { if (xb_ld(&(bar)[XB_TMO])) break; if (_sp > XB_SPIN_CAP) { atomicAdd(&(bar)[XB_TMO], 1u); break; } } } } while (0)
struct XcdBarrier { unsigned* bar; unsigned x; volatile LAS unsigned* st; };
__device__ __forceinline__ void xcd_barrier_complete(unsigned* bar, unsigned x, unsigned& nloc, unsigned& nx) {
    const unsigned G = gridDim.x;
    unsigned sum, cnt, mine, sp = 0u;
    for (;;) {
        sum = 0u; cnt = 0u; mine = 0u;
#pragma unroll
        for (unsigned j = 0; j < 16; ++j) { const unsigned c = xb_ld(&bar[XB_XCNT(j)]); sum += c; cnt += (c > 0u) ? 1u : 0u; mine = (j == x) ? c : mine; }
        if (sum == G) break;
        __builtin_amdgcn_s_sleep(1);
        if ((++sp & 255u) == 0u) { if (xb_ld(&bar[XB_TMO])) break; if (sp > XB_SPIN_CAP) { atomicAdd(&bar[XB_TMO], 1u); break; } }
    }
    nloc = mine > 0u ? mine : 1u; nx = cnt > 0u ? cnt : 1u;
}
__device__ __forceinline__ void xcd_barrier(const XcdBarrier& b, int tid) {
    asm volatile("s_waitcnt vmcnt(0)" ::: "memory");
    __syncthreads();
    if (tid == 0) {
        unsigned* bar = b.bar;
        __builtin_amdgcn_s_waitcnt(0);
        unsigned nloc = b.st[0], nx = b.st[1];
        if (nloc == 0u) { xcd_barrier_complete(bar, b.x, nloc, nx); b.st[0] = nloc; b.st[1] = nx; }
        const unsigned old = xb_add(&bar[XB_XSUB(b.x)], 1u);
        const unsigned gen = old / nloc;
        if (old + 1u == (gen + 1u) * nloc) {
            __builtin_amdgcn_fence(__ATOMIC_RELEASE, "agent");
            asm volatile("s_waitcnt vmcnt(0)" ::: "memory");
            const unsigned og = xb_add(&bar[XB_TOP], 1u);
            const unsigned tg = og / nx;
            if (og + 1u == (tg + 1u) * nx) xb_add(&bar[XB_TOPGEN], 1u);
            else XB_SPIN(xb_ld(&bar[XB_TOPGEN]) == tg, bar);
            __builtin_amdgcn_fence(__ATOMIC_ACQUIRE, "agent");
            xb_add(&bar[XB_XGEN(b.x)], 1u);
            asm volatile("s_waitcnt vmcnt(0)" ::: "memory");
        } else {
            XB_SPIN(xb_ld(&bar[XB_XGEN(b.x)]) == gen, bar);
            __builtin_amdgcn_fence(__ATOMIC_ACQUIRE, "agent");
            asm volatile("s_waitcnt vmcnt(0)" ::: "memory");
        }
    }
    __syncthreads();
}

__global__ void __launch_bounds__(512, 2) fwd_kernel(Args args) {
    extern __shared__ __attribute__((aligned(16))) unsigned char lds_raw[];
    Frame F;
    F.lds = (LAS unsigned char*)lds_raw;
    F.wave = __builtin_amdgcn_readfirstlane(threadIdx.x >> 6);
    F.G = gridDim.x; F.bid = blockIdx.x; F.ws = args.ws;
    unsigned char* ws = args.ws;
    const int lo = args.ph_lo, hi = args.ph_hi;
    XcdBarrier bar; bar.bar = (unsigned*)(ws + WS_BAR); bar.st = (volatile LAS unsigned*)(F.lds + LDS_BYTES - 64); bar.x = xb_xcc_id();
#if MK_COOP
    if (hi > NPH) cg::this_grid().sync();
    if (threadIdx.x == 0) { bar.st[0] = 0u; bar.st[1] = 0u; (void)xb_add(&bar.bar[XB_XCNT(bar.x)], 1u); }
#endif
    const float* VEC = (const float*)(ws + WS_VEC); const float* BIAS = (const float*)(ws + WS_BIAS);
    float* SSQA = (float*)(ws + WS_SSQA); float* SSQB = (float*)(ws + WS_SSQB);
    bf16_t* XB = (bf16_t*)(ws + WS_XB); bf16_t* XB2 = (bf16_t*)(ws + WS_XB2); bf16_t* ACT = (bf16_t*)(ws + WS_BIG);
    const bf16_t* WIN = (const bf16_t*)(ws + WS_WIN); const bf16_t* WOUT = (const bf16_t*)(ws + WS_WOUT);
    float* X = args.out;
    bf16_t* X16 = (bf16_t*)args.out;
    bf16_t* X5 = (bf16_t*)(ws + WS_SLOT2);
    LAS float* RED = (LAS float*)(F.lds + 131072 + 4096);
#define VWK(sub) (VEC + ((0 * 7 + (sub)) * 2) * D)
#define VGC(sub) (VEC + ((2 * 7 + (sub)) * 2) * D)
#if MK_COOP
#define SEAM(k) do { if ((k) + 1 < hi) xcd_barrier(bar, F.wave * 64 + lane_id()); } while (0)
#else
#define SEAM(k) do { } while (0)
#endif
#ifndef PHMASK
#define PHMASK 0xffffffffu
#endif
#define IN(k) (((PHMASK >> (k)) & 1u) && lo <= (k) && (k) < hi)
#define GEMM1(f, A_, ssq_) do { pg8::Gemm g{A_, WIN + (size_t)(f) * NIN * D, M, NIN, D, D, 0}; pg8::StaticOrder S; S.init(M, NIN, F.G, F.bid); \
        pg8::EpiSwiglu E{ACT, BIAS + (f) * 2 * NIN, ssq_}; pg8::gemm_phase(F.lds, g, S, E, F.wave); } while (0)
#define GEMM2(IN16_, OUT16_, f, xin_, xout_, sub_, xb1_, wk1_, xb2_, wk2_, ssq_) do { pg8::Gemm g{ACT, WOUT + (size_t)(f) * D * FF, M, D, FF, FF, 0}; pg8::StaticOrder S; S.init(M, D, F.G, F.bid, 1); \
        pg8::EpiResid<IN16_, OUT16_> E{xin_, xout_, VGC(sub_), xb1_, wk1_, xb2_, wk2_, ssq_, RED}; pg8::gemm_phase(F.lds, g, S, E, F.wave); } while (0)

#ifndef DUPMASK
#define DUPMASK 0u
#endif
#if MK_COOP
#define DUPBAR() xcd_barrier(bar, F.wave * 64 + lane_id())
#else
#define DUPBAR() do { } while (0)
#endif
#define PH(k, ...) if (IN(k)) { __VA_ARGS__; if ((DUPMASK >> (k)) & 1u) { DUPBAR(); __VA_ARGS__; } SEAM(k); }
    PH(0, phase0(F, args))
    PH(1, phase1(F, args))
    PH(2, phase2(F, args))
    PH(3, GEMM1(0, XB, SSQA))
    PH(4, GEMM2(false, true, 0, args.in[0], X16, 0, (bf16_t*)nullptr, (const float*)nullptr, (bf16_t*)nullptr, (const float*)nullptr, SSQB))
    PH(5, phase_pool_elem(F, X16, SSQB))
    PH(6, { pg8::Gemm g{XB2, (const bf16_t*)(ws + WS_WPOOL), M, D, 256, D, 256}; pg8::StaticOrder S; S.init(M, D, F.G, F.bid, 1);
        pg8::EpiResid<true, true> E{X16, X16, VGC(1), XB, VWK(2), (bf16_t*)nullptr, (const float*)nullptr, SSQA, RED}; pg8::gemm_phase(F.lds, g, S, E, F.wave); })
    PH(7, GEMM1(1, XB, SSQA))
    PH(8, GEMM2(true, true, 1, X16, X16, 2, XB, VWK(3), XB2, VWK(6), SSQB))
    PH(9, GEMM1(2, XB, SSQB))
    PH(10, GEMM2(true, true, 2, X16, X16, 3, XB, VWK(4), (bf16_t*)nullptr, (const float*)nullptr, SSQA))
    PH(11, {
        { pg8::Gemm g{XB, (const bf16_t*)(ws + WS_WQ), M, D, D, D, 0}; pg8::StaticOrder S; S.init(M, D, F.G, F.bid);
          pg8::EpiProj E{BIAS + 8 * NIN + 4 * D, D, SSQA, (bf16_t*)(ws + WS_QN), (bf16_t*)nullptr}; pg8::gemm_phase(F.lds, g, S, E, F.wave); }
        { pg8::Gemm g{XB2, (const bf16_t*)(ws + WS_WKV), M, 2 * D, D, D, 0}; pg8::StaticOrder S; S.init(M, 2 * D, F.G, F.bid);
          pg8::EpiProj E{BIAS + 8 * NIN, 2 * D, SSQB, (bf16_t*)(ws + WS_KN), (bf16_t*)(ws + WS_VT)}; pg8::gemm_phase(F.lds, g, S, E, F.wave); } })
#if defined(PROBE_KVPREP)
    PH(12, { phase_kvprep(F, args); DUPBAR();
        { pg8::Gemm g{XB2, (const bf16_t*)(ws + WS_WKV), M, 2 * D, D, D, 0}; pg8::StaticOrder S; S.init(M, 2 * D, F.G, F.bid);
          pg8::EpiProj E{BIAS + 8 * NIN, 2 * D, SSQB, (bf16_t*)(ws + WS_KN), (bf16_t*)(ws + WS_VT)}; pg8::gemm_phase(F.lds, g, S, E, F.wave); }
        DUPBAR(); phase_kvprep(F, args); })
#else
    PH(12, phase_kvprep(F, args))
#endif
    PH(13, phase_sel(F, args))
#ifndef P1VAR
#define P1VAR 0
#endif
    if (IN(14)) { phase_part1<0>(F, 0); if (P1VAR) { DUPBAR(); phase_part1<P1VAR>(F, 0); } SEAM(14); }
    PH(15, phase_part2(F, 0))
    PH(16, phase_part1<0>(F, 1))
    PH(17, phase_part2(F, 1))
    PH(18, { pg8::Gemm g{XB, (const bf16_t*)(ws + WS_WO), M, D, D, D, 0}; pg8::StaticOrder S; S.init(M, D, F.G, F.bid, 1);
        pg8::EpiResid<true, true> E{X16, X5, VGC(4), XB2, VWK(5), (bf16_t*)nullptr, (const float*)nullptr, SSQA, RED}; pg8::gemm_phase(F.lds, g, S, E, F.wave); })
    PH(19, GEMM1(3, XB2, SSQA))
    PH(20, GEMM2(true, false, 3, X5, X, 5, (bf16_t*)nullptr, (const float*)nullptr, (bf16_t*)nullptr, (const float*)nullptr, (float*)nullptr))
}

extern "C" void kernel_launch(void* const* d_in, const int* in_sizes, int n_in, void* d_out, int out_size, void* d_ws, size_t ws_size, hipStream_t stream) {
    static int grid = 0;
    if (grid == 0) {
        if (n_in != 17 || in_sizes[0] != M * D || out_size != M * D || ws_size < WS_END) { fprintf(stderr, "kernel_launch: unexpected shapes (n_in %d, in0 %d, out %d, ws %zu < %zu)\n", n_in, n_in > 0 ? in_sizes[0] : -1, out_size, ws_size, (size_t)WS_END); grid = -1; return; }
        int dev = 0, cus = 0, per_cu = 0;
        if (hipGetDevice(&dev) != hipSuccess || hipDeviceGetAttribute(&cus, hipDeviceAttributeMultiprocessorCount, dev) != hipSuccess) { grid = -1; return; }
        if (hipFuncSetAttribute((const void*)fwd_kernel, hipFuncAttributeMaxDynamicSharedMemorySize, LDS_BYTES) != hipSuccess) { fprintf(stderr, "kernel_launch: hipFuncSetAttribute failed\n"); grid = -1; return; }
        if (hipOccupancyMaxActiveBlocksPerMultiprocessor(&per_cu, (const void*)fwd_kernel, 512, LDS_BYTES) != hipSuccess || per_cu < 1) { fprintf(stderr, "kernel_launch: occupancy query says %d\n", per_cu); per_cu = 1; }
        (void)hipGetLastError();
        grid = cus * 1;
    }
    if (grid < 0) return;
    if (hipMemsetAsync(d_ws, 0, 65536, stream) != hipSuccess) { fprintf(stderr, "kernel_launch: memset failed\n"); return; }
    Args a{};
    for (int i = 0; i < 17; ++i) a.in[i] = (const float*)d_in[i];
    a.out = (float*)d_out; a.ws = (unsigned char*)d_ws;
#if MK_COOP
    a.ph_lo = 0; a.ph_hi = NPH;
    void* kargs[] = {&a};
    hipError_t e = hipLaunchCooperativeKernel((const void*)fwd_kernel, dim3(grid), dim3(512), kargs, LDS_BYTES, stream);
    if (e != hipSuccess) fprintf(stderr, "cooperative launch failed: %s (grid %d)\n", hipGetErrorString(e), grid);
#else
    for (int p = 0; p < NPH; ++p) { a.ph_lo = p; a.ph_hi = p + 1; hipLaunchKernelGGL(fwd_kernel, dim3(grid), dim3(512), LDS_BYTES, stream, a); }
#endif
}
```

```cpp
#include <hip/hip_runtime.h>
#include <hip/hip_cooperative_groups.h>
#include <cstdio>
#include <cstdint>
namespace cg = cooperative_groups;

#ifndef MK_COOP
#define MK_COOP 1
#endif

#define LAS __attribute__((address_space(3)))
typedef unsigned short bf16_t;
typedef short bf16x8 __attribute__((ext_vector_type(8)));
typedef float f32x4 __attribute__((ext_vector_type(4)));
typedef float f32x16 __attribute__((ext_vector_type(16)));
typedef unsigned u32x4 __attribute__((ext_vector_type(4)));
typedef unsigned u32x2 __attribute__((ext_vector_type(2)));
typedef float f32x2_t __attribute__((ext_vector_type(2)));
typedef __bf16 bf16x2_t __attribute__((ext_vector_type(2)));

constexpr int BATCH = 2, T = 16384, D = 1024, FF = 2816, NH = 8, HD = 128, NBLK = 64, BS = 256;
constexpr int M = BATCH * T;
constexpr int NIN = 2 * FF;
constexpr float EPS = 1e-6f;
constexpr int NMODCOL = 2 * 9 * D + 2 * D;
constexpr int KSPLIT = 16;

constexpr size_t MiB = 1u << 20;
constexpr size_t WS_CNT = 0;
constexpr size_t WS_BAR = 16384;
constexpr size_t WS_CREF = 8192;
constexpr size_t WS_MODP = 64 * 1024;
constexpr size_t WS_VEC = 3 * MiB;
constexpr size_t WS_BIAS = 3 * MiB + 256 * 1024;
constexpr size_t WS_KMEAN = 3 * MiB + 512 * 1024;
constexpr size_t WS_SSQA = 4 * MiB, WS_SSQB = 6 * MiB;
constexpr size_t WS_ROPE = 8 * MiB;
constexpr size_t WS_LS = 16 * MiB;
constexpr size_t WS_WIN = 20 * MiB;
constexpr size_t WS_WOUT = 64 * MiB;
constexpr size_t WS_WKV = 86 * MiB, WS_WQ = 90 * MiB, WS_WO = 92 * MiB, WS_WPOOL = 94 * MiB;
constexpr size_t WS_XB = 95 * MiB;
constexpr size_t WS_XB2 = 159 * MiB;
constexpr size_t WS_BIG = 223 * MiB;
constexpr size_t WS_KN = WS_BIG, WS_VT = WS_BIG + 64 * MiB, WS_QN = WS_BIG + 128 * MiB;
constexpr size_t WS_SLOT2 = WS_BIG + 192 * MiB;
constexpr size_t WS_LIST = WS_SLOT2 + 32 * MiB;
constexpr size_t WS_END = WS_LIST + 32 * MiB;
static_assert(WS_END <= 512 * MiB, "ws map");

constexpr int LDS_BYTES = 147456;
constexpr int NWAVES = 8;
constexpr int NPH = 21;

__device__ __forceinline__ int lane_id() { int l; asm volatile("v_mbcnt_lo_u32_b32 %0, -1, 0\n\tv_mbcnt_hi_u32_b32 %0, -1, %0" : "=v"(l)); return l; }
__device__ __forceinline__ unsigned cvtpk(float lo, float hi) { f32x2_t v = {lo, hi}; bf16x2_t b = __builtin_convertvector(v, bf16x2_t); return __builtin_bit_cast(unsigned, b); }
__device__ __forceinline__ float bflo(unsigned w) { return __uint_as_float(w << 16); }
__device__ __forceinline__ float bfhi(unsigned w) { return __uint_as_float(w & 0xffff0000u); }
__device__ __forceinline__ float wave_sum(float v) {
#pragma unroll
    for (int o = 1; o < 64; o <<= 1) v += __shfl_xor(v, o);
    return v;
}
__device__ __forceinline__ float rstd_from(const f32x4 a) { return __builtin_amdgcn_rsqf(((a[0] + a[1]) + (a[2] + a[3])) * (1.0f / D) + EPS); }
__device__ __forceinline__ float rstd_of(const float* p) { return rstd_from(*(const f32x4*)p); }
__device__ __forceinline__ float silu_mul(float g, float u) { return g * __builtin_amdgcn_rcpf(1.0f + __builtin_amdgcn_exp2f(-1.4426950408889634f * g)) * u; }

namespace pg8 {
constexpr int BM = 256, BK = 64, HALF = 128, HTB = HALF * BK * 2, STAGE_BYTES = 8 * HTB, NXCD = 8, WGM = 8;
__host__ __device__ __forceinline__ int lds_byte(int r, int c) { const int st = (r >> 4) * 2 + (c >> 5), rr = r & 15, cc = c & 31, ob = rr * 64 + cc * 2; return st * 1024 + (ob ^ (((ob >> 9) & 1) << 5)); }
__host__ __device__ __forceinline__ void stage_rc(int b, int& R, int& C) { const int st = b / 1024, sb = b % 1024, swz = sb ^ (((sb >> 9) & 1) << 5); R = (st >> 1) * 16 + swz / 64; C = (st & 1) * 32 + (swz % 64) / 2; }
__host__ __device__ __forceinline__ int perm32(int rho) { const int n = rho >> 4, i = rho & 15; return 8 * (i >> 2) + 4 * n + (i & 3); }

struct Unit { int pm, pn; };
struct Gemm { const bf16_t* A; const bf16_t* Bt; int M, N, K, lda, acol; };

struct StaticOrder {
    int nM, nN, nwg, G, c;
    __host__ __device__ __forceinline__ void init(int M_, int N_, int G_, int c_, int rev_ = 0) { nM = M_ / BM; nN = N_ / BM; nwg = nM * nN; G = G_; c = c_;
        if (rev_ && nwg == 2 * G_) { c = c_ + G_; G = -G_; } }
    __host__ __device__ __forceinline__ bool next(int i, Unit& u) const {
        const int L = i * G + c; if (L >= nwg || L < 0) return false;
        int wgid = (int)L; { const int q = nwg / NXCD, r = nwg % NXCD, xcd = wgid % NXCD, off = wgid / NXCD; wgid = (xcd < r ? xcd * (q + 1) : r * (q + 1) + (xcd - r) * q) + off; }
        const int nig = WGM * nN, gid = wgid / nig, fm = gid * WGM, gsz = (nM - fm) < WGM ? (nM - fm) : WGM;
        u.pm = fm + ((wgid % nig) % gsz); u.pn = (wgid % nig) / gsz; return true;
    }
};

template <class Epi>
__device__ __forceinline__ void gemm_phase(LAS unsigned char* lds, const Gemm g, const StaticOrder& S, const Epi& E, int wid) {
    const int lane = lane_id(), tid = wid * 64 + lane, wr = wid >> 2, wc = wid & 3, fr = lane & 15, fq = lane >> 4;
    const int K = g.K, nt = K / BK, lda = g.lda;
    unsigned voffA[2], voffB[2];
#pragma unroll
    for (int i = 0; i < 2; ++i) { int R, C; stage_rc(tid * 16 + i * 8192, R, C); const int Rb = (R & ~31) + perm32(R & 31);
        voffA[i] = (unsigned)(R * lda + C) * 2u; voffB[i] = (unsigned)(Rb * K + C) * 2u; }
    const size_t kstep = (size_t)(BK * 2);
    const size_t hstepA = (size_t)HALF * lda * 2, hstepB = (size_t)HALF * K * 2;
    const size_t tstepA = 2 * hstepA, tstepB = 2 * hstepB;
    const size_t acolb = (size_t)g.acol * 2;
    const unsigned ldsw = (unsigned)wid * 1024u;
    const int aoff = lds_byte(wr * 64 + fr, fq * 8), boff = lds_byte(wc * 32 + fr, fq * 8);
#define PG8_SA(b, h) (((b) * 2 + (h)) * HTB)
#define PG8_SB(b, h) ((4 + (b) * 2 + (h)) * HTB)
#define PG8_STAGE(bufoff, gbase, voff) do { _Pragma("unroll") for (int _i = 0; _i < 2; ++_i) \
        __builtin_amdgcn_global_load_lds((const unsigned*)((const char*)(gbase) + (voff)[_i]), (LAS unsigned*)(lds + (bufoff) + ldsw + _i * 8192), 16, 0, 0); } while (0)
#define PG8_LDA(dst, b, h) do { _Pragma("unroll") for (int m = 0; m < 4; ++m) _Pragma("unroll") for (int k = 0; k < 2; ++k) dst[m][k] = *(const LAS bf16x8*)(lds + PG8_SA(b, h) + aoff + m * 2048 + k * 1024); } while (0)
#define PG8_LDB(dst, b, h) do { _Pragma("unroll") for (int n = 0; n < 2; ++n) _Pragma("unroll") for (int k = 0; k < 2; ++k) dst[n][k] = *(const LAS bf16x8*)(lds + PG8_SB(b, h) + boff + n * 2048 + k * 1024); } while (0)
#define PG8_MMA(ai, bj, At, Bt) do { __builtin_amdgcn_s_setprio(1); _Pragma("unroll") for (int m = 0; m < 4; ++m) _Pragma("unroll") for (int n = 0; n < 2; ++n) _Pragma("unroll") for (int k = 0; k < 2; ++k) \
        acc[ai][bj][m][n] = __builtin_amdgcn_mfma_f32_16x16x32_bf16(Bt[n][k], At[m][k], acc[ai][bj][m][n], 0, 0, 0); __builtin_amdgcn_s_setprio(0); } while (0)
#define PG8_WAIT_V(n) asm volatile("s_waitcnt vmcnt(" #n ")" ::: "memory")
#define PG8_WAIT_L(n) asm volatile("s_waitcnt lgkmcnt(" #n ")" ::: "memory")
#define PG8_BAR __builtin_amdgcn_s_barrier()
#define PG8_SCHED __builtin_amdgcn_sched_barrier(0)
    Unit cur, nxt; int ui = 0;
    if (!S.next(0, cur)) return;
    f32x4 acc[2][2][4][2];
#pragma unroll
    for (int a = 0; a < 2; ++a)
#pragma unroll
        for (int b = 0; b < 2; ++b)
#pragma unroll
            for (int m = 0; m < 4; ++m)
#pragma unroll
                for (int n = 0; n < 2; ++n) acc[a][b][m][n] = (f32x4){0.f, 0.f, 0.f, 0.f};
    bf16x8 At[4][2], B0[2][2], B1[2][2];
    const char* cA = (const char*)g.A + (size_t)cur.pm * tstepA + (size_t)cur.pn * acolb; const char* cB = (const char*)g.Bt + (size_t)cur.pn * tstepB;
    PG8_STAGE(PG8_SB(0, 0), cB, voffB); PG8_STAGE(PG8_SB(0, 1), cB + hstepB, voffB); PG8_STAGE(PG8_SA(0, 0), cA, voffA); PG8_STAGE(PG8_SA(0, 1), cA + hstepA, voffA);
    if (wr == 1) PG8_BAR;
    PG8_WAIT_V(2); PG8_BAR;
    PG8_STAGE(PG8_SB(1, 0), cB + kstep, voffB); PG8_STAGE(PG8_SA(1, 0), cA + kstep, voffA); PG8_STAGE(PG8_SB(1, 1), cB + hstepB + kstep, voffB);
    PG8_WAIT_V(6); PG8_BAR;
    for (;;) {
        const bool has_next = S.next(ui + 1, nxt);
        const char* nA = has_next ? (const char*)g.A + (size_t)nxt.pm * tstepA + (size_t)nxt.pn * acolb : cA; const char* nB = has_next ? (const char*)g.Bt + (size_t)nxt.pn * tstepB : cB;
#pragma nounroll
        for (int t = 0; t < nt; t += 2) {
            const bool last = (t == nt - 2);
            const char* a1 = cA + (size_t)(t + 1) * kstep;
            const char* a2 = last ? nA : cA + (size_t)(t + 2) * kstep; const char* b2 = last ? nB : cB + (size_t)(t + 2) * kstep;
            const char* a3 = a2 + kstep; const char* b3 = b2 + kstep;
            PG8_LDB(B0, 0, 0); PG8_LDB(B1, 0, 1); PG8_SCHED; PG8_LDA(At, 0, 0); PG8_STAGE(PG8_SA(1, 1), a1 + hstepA, voffA);
            PG8_WAIT_V(8); PG8_WAIT_L(0); PG8_BAR; PG8_MMA(0, 0, At, B0); PG8_MMA(0, 1, At, B1); PG8_BAR; PG8_SCHED;
            PG8_LDA(At, 0, 1); PG8_STAGE(PG8_SB(0, 0), b2, voffB); PG8_STAGE(PG8_SB(0, 1), b2 + hstepB, voffB); PG8_STAGE(PG8_SA(0, 0), a2, voffA);
            PG8_WAIT_V(8); PG8_WAIT_L(0); PG8_BAR; PG8_MMA(1, 0, At, B0); PG8_MMA(1, 1, At, B1); PG8_BAR; PG8_SCHED;
            PG8_LDB(B0, 1, 0); PG8_LDB(B1, 1, 1); PG8_SCHED; PG8_LDA(At, 1, 0); PG8_STAGE(PG8_SA(0, 1), a2 + hstepA, voffA);
            PG8_WAIT_V(8); PG8_WAIT_L(0); PG8_BAR; PG8_MMA(0, 0, At, B0); PG8_MMA(0, 1, At, B1); PG8_BAR; PG8_SCHED;
            PG8_LDA(At, 1, 1); PG8_STAGE(PG8_SB(1, 0), b3, voffB); PG8_STAGE(PG8_SB(1, 1), b3 + hstepB, voffB); PG8_STAGE(PG8_SA(1, 0), a3, voffA);
            PG8_WAIT_V(8); PG8_WAIT_L(0); PG8_BAR; PG8_MMA(1, 0, At, B0); PG8_MMA(1, 1, At, B1); PG8_BAR; PG8_SCHED;
        }
        if (wr == 0) PG8_BAR;
        E(acc, cur, wr, wc, fr, fq);
        if (!has_next) break;
#pragma unroll
        for (int a = 0; a < 2; ++a)
#pragma unroll
            for (int b = 0; b < 2; ++b)
#pragma unroll
                for (int m = 0; m < 4; ++m)
#pragma unroll
                    for (int n = 0; n < 2; ++n) acc[a][b][m][n] = (f32x4){0.f, 0.f, 0.f, 0.f};
        cur = nxt; cA = nA; cB = nB; ++ui;
        if (wr == 1) PG8_BAR;
    }
    PG8_WAIT_V(0);
    PG8_BAR;
#undef PG8_SA
#undef PG8_SB
#undef PG8_STAGE
#undef PG8_LDA
#undef PG8_LDB
#undef PG8_MMA
#undef PG8_WAIT_V
#undef PG8_WAIT_L
#undef PG8_BAR
#undef PG8_SCHED
}

struct EpiSwiglu {
    bf16_t* O; const float* bias; const float* ssq;
    __device__ __forceinline__ void operator()(const f32x4 (&acc)[2][2][4][2], const Unit& u, int wr, int wc, int fr_, int fq_) const {
        int fr = fr_, fq = fq_; asm volatile("" : "+v"(fr), "+v"(fq));
        const int b = u.pm >= (T / BM) ? 1 : 0;
        const float* bp = bias + b * NIN + u.pn * 256 + wc * 32 + 8 * fq;
        const f32x4 bg0 = *(const f32x4*)bp, bg1 = *(const f32x4*)(bp + 4), bu0 = *(const f32x4*)(bp + 128), bu1 = *(const f32x4*)(bp + 132);
        f32x4 sq[2][4];
#pragma unroll
        for (int ai = 0; ai < 2; ++ai)
#pragma unroll
            for (int m = 0; m < 4; ++m) sq[ai][m] = *(const f32x4*)(ssq + (size_t)(u.pm * BM + ai * HALF + wr * 64 + m * 16 + fr) * 4);
#pragma unroll
        for (int ai = 0; ai < 2; ++ai)
#pragma unroll
            for (int m = 0; m < 4; ++m) {
                const int row = u.pm * BM + ai * HALF + wr * 64 + m * 16 + fr;
                const float rs = rstd_from(sq[ai][m]);
                const f32x4 g0 = acc[ai][0][m][0] * rs + bg0, g1 = acc[ai][0][m][1] * rs + bg1, u0 = acc[ai][1][m][0] * rs + bu0, u1 = acc[ai][1][m][1] * rs + bu1;
                const f32x4 a0 = g0 * -1.4426950408889634f, a1 = g1 * -1.4426950408889634f;
                f32x4 e0, e1;
#pragma unroll
                for (int i = 0; i < 4; ++i) { e0[i] = __builtin_amdgcn_exp2f(a0[i]); e1[i] = __builtin_amdgcn_exp2f(a1[i]); }
                e0 = e0 + 1.0f; e1 = e1 + 1.0f;
                f32x4 r0, r1;
#pragma unroll
                for (int i = 0; i < 4; ++i) { r0[i] = __builtin_amdgcn_rcpf(e0[i]); r1[i] = __builtin_amdgcn_rcpf(e1[i]); }
                const f32x4 o0 = (g0 * u0) * r0, o1 = (g1 * u1) * r1;
                u32x4 w;
                w.x = cvtpk(o0[0], o0[1]); w.y = cvtpk(o0[2], o0[3]); w.z = cvtpk(o1[0], o1[1]); w.w = cvtpk(o1[2], o1[3]);
                __builtin_nontemporal_store(w, (u32x4*)(O + (size_t)row * FF + u.pn * 128 + wc * 32 + 8 * fq));
            }
    }
};
template <bool IN16, bool OUT16>
struct EpiResid {
    const void* xin; void* xout; const float* gc; bf16_t* xb1; const float* wk1; bf16_t* xb2; const float* wk2; float* ssq; LAS float* red;
    __device__ __forceinline__ void operator()(const f32x4 (&acc)[2][2][4][2], const Unit& u, int wr, int wc, int fr_, int fq_) const {
        int fr = fr_, fq = fq_; asm volatile("" : "+v"(fr), "+v"(fq));
        const int b = u.pm >= (T / BM) ? 1 : 0;
        const int col0 = u.pn * 256 + wc * 32 + 8 * fq;
        f32x4 gv[2][2];
#pragma unroll
        for (int bj = 0; bj < 2; ++bj) { gv[bj][0] = *(const f32x4*)(gc + b * D + col0 + bj * HALF); gv[bj][1] = *(const f32x4*)(gc + b * D + col0 + bj * HALF + 4); }
#pragma unroll
        for (int ai = 0; ai < 2; ++ai)
#pragma unroll
            for (int mp = 0; mp < 4; mp += 2) {
                f32x4 xr[2][2][2]; u32x4 xh[2][2];
#pragma unroll
                for (int mm = 0; mm < 2; ++mm)
#pragma unroll
                    for (int bj = 0; bj < 2; ++bj) { const size_t off = (size_t)(u.pm * BM + ai * HALF + wr * 64 + (mp + mm) * 16 + fr) * D + col0 + bj * HALF;
                        if (IN16) xh[mm][bj] = *(const u32x4*)((const bf16_t*)xin + off);
                        else { xr[mm][bj][0] = *(const f32x4*)((const float*)xin + off); xr[mm][bj][1] = *(const f32x4*)((const float*)xin + off + 4); } }
#pragma unroll
                for (int mm = 0; mm < 2; ++mm) {
                    const int m = mp + mm, rl = ai * HALF + wr * 64 + m * 16 + fr, row = u.pm * BM + rl;
                    float s = 0.f;
#pragma unroll
                    for (int bj = 0; bj < 2; ++bj) {
                        const size_t off = (size_t)row * D + col0 + bj * HALF;
                        f32x4 x0, x1;
                        if (IN16) { const u32x4 h = xh[mm][bj]; x0 = (f32x4){bflo(h.x), bfhi(h.x), bflo(h.y), bfhi(h.y)}; x1 = (f32x4){bflo(h.z), bfhi(h.z), bflo(h.w), bfhi(h.w)}; }
                        else { x0 = xr[mm][bj][0]; x1 = xr[mm][bj][1]; }
                        const f32x4 v0 = x0 + gv[bj][0] * acc[ai][bj][m][0], v1 = x1 + gv[bj][1] * acc[ai][bj][m][1];
                        if (OUT16) { u32x4 w; w.x = cvtpk(v0[0], v0[1]); w.y = cvtpk(v0[2], v0[3]); w.z = cvtpk(v1[0], v1[1]); w.w = cvtpk(v1[2], v1[3]); *(u32x4*)((bf16_t*)xout + off) = w; }
                        else { *(f32x4*)((float*)xout + off) = v0; *(f32x4*)((float*)xout + off + 4) = v1; }
                        s += (v0[0] * v0[0] + v0[1] * v0[1]) + (v0[2] * v0[2] + v0[3] * v0[3]) + (v1[0] * v1[0] + v1[1] * v1[1]) + (v1[2] * v1[2] + v1[3] * v1[3]);
                        if (xb1) { const float* wp = wk1 + b * D + col0 + bj * HALF; const f32x4 w0 = *(const f32x4*)wp, w1 = *(const f32x4*)(wp + 4);
                            u32x4 w; w.x = cvtpk(v0[0] * w0[0], v0[1] * w0[1]); w.y = cvtpk(v0[2] * w0[2], v0[3] * w0[3]); w.z = cvtpk(v1[0] * w1[0], v1[1] * w1[1]); w.w = cvtpk(v1[2] * w1[2], v1[3] * w1[3]);
                            *(u32x4*)(xb1 + off) = w; }
                        if (xb2) { const float* wp = wk2 + b * D + col0 + bj * HALF; const f32x4 w0 = *(const f32x4*)wp, w1 = *(const f32x4*)(wp + 4);
                            u32x4 w; w.x = cvtpk(v0[0] * w0[0], v0[1] * w0[1]); w.y = cvtpk(v0[2] * w0[2], v0[3] * w0[3]); w.z = cvtpk(v1[0] * w1[0], v1[1] * w1[1]); w.w = cvtpk(v1[2] * w1[2], v1[3] * w1[3]);
                            *(u32x4*)(xb2 + off) = w; }
                    }
                    if (ssq) { s += __shfl_xor(s, 16); s += __shfl_xor(s, 32); if (fq == 0) red[rl * 4 + wc] = s; }
                }
                asm volatile("" ::: "memory");
            }
        if (ssq) {
            asm volatile("s_waitcnt lgkmcnt(0)" ::: "memory"); __builtin_amdgcn_s_barrier(); asm volatile("" ::: "memory");
            const int tid = (wr * 4 + wc) * 64 + fq * 16 + fr;
            if (tid < 256) { const f32x4 p = *(const LAS f32x4*)(red + tid * 4); ssq[(size_t)(u.pm * BM + tid) * 4 + u.pn] = (p[0] + p[1]) + (p[2] + p[3]); }
            asm volatile("s_waitcnt lgkmcnt(0)" ::: "memory"); __builtin_amdgcn_s_barrier(); asm volatile("" ::: "memory");
        }
    }
};
struct EpiProj {
    const float* bias; int N; const float* ssq; bf16_t* dstH; bf16_t* dstVT;
    __device__ __forceinline__ void operator()(const f32x4 (&acc)[2][2][4][2], const Unit& u, int wr, int wc, int fr_, int fq_) const {
        int fr = fr_, fq = fq_; asm volatile("" : "+v"(fr), "+v"(fq));
        const int b = u.pm >= (T / BM) ? 1 : 0, blk = u.pm & (NBLK - 1);
        float rs[2][4];
#pragma unroll
        for (int ai = 0; ai < 2; ++ai)
#pragma unroll
            for (int m = 0; m < 4; ++m) rs[ai][m] = rstd_of(ssq + (size_t)(u.pm * BM + ai * HALF + wr * 64 + m * 16 + fr) * 4);
        const float* bp = bias + b * N + u.pn * 256 + wc * 32 + 8 * fq;
        if (u.pn < 4) {
#pragma unroll
            for (int bj = 0; bj < 2; ++bj) {
                f32x4 bv[2][2]; bv[bj][0] = *(const f32x4*)(bp + bj * HALF); bv[bj][1] = *(const f32x4*)(bp + bj * HALF + 4);
                const int h = 2 * u.pn + bj;
                bf16_t* hb = dstH + ((size_t)(b * NH + h) * T + blk * BS) * HD + wc * 32 + 8 * fq;
#pragma unroll
                for (int ai = 0; ai < 2; ++ai)
#pragma unroll
                    for (int m = 0; m < 4; ++m) {
                        const f32x4 v0 = acc[ai][bj][m][0] * rs[ai][m] + bv[bj][0], v1 = acc[ai][bj][m][1] * rs[ai][m] + bv[bj][1];
                        u32x4 w; w.x = cvtpk(v0[0], v0[1]); w.y = cvtpk(v0[2], v0[3]); w.z = cvtpk(v1[0], v1[1]); w.w = cvtpk(v1[2], v1[3]);
                        *(u32x4*)(hb + (unsigned)((ai * HALF + wr * 64 + m * 16 + fr) * HD)) = w;
                        asm volatile("" ::: "memory");
                    }
            }
        } else {
            const int pc = 16 * wr + fr;
#pragma unroll
            for (int bj = 0; bj < 2; ++bj) {
                f32x4 bv[2][2]; bv[bj][0] = *(const f32x4*)(bp + bj * HALF); bv[bj][1] = *(const f32x4*)(bp + bj * HALF + 4);
                const int h = 2 * (u.pn - 4) + bj;
                bf16_t* vb = dstVT + ((size_t)(b * NH + h) * NBLK + blk) * (HD * BS);
#pragma unroll
                for (int n = 0; n < 2; ++n)
#pragma unroll
                    for (int i = 0; i < 4; ++i) {
                        const int d = wc * 32 + 8 * fq + 4 * n + i;
                        const float bb = bv[bj][n][i];
                        u32x4 w;
                        w.x = cvtpk(acc[0][bj][0][n][i] * rs[0][0] + bb, acc[0][bj][1][n][i] * rs[0][1] + bb);
                        w.y = cvtpk(acc[0][bj][2][n][i] * rs[0][2] + bb, acc[0][bj][3][n][i] * rs[0][3] + bb);
                        w.z = cvtpk(acc[1][bj][0][n][i] * rs[1][0] + bb, acc[1][bj][1][n][i] * rs[1][1] + bb);
                        w.w = cvtpk(acc[1][bj][2][n][i] * rs[1][2] + bb, acc[1][bj][3][n][i] * rs[1][3] + bb);
                        *(u32x4*)(vb + (unsigned)(d * BS + ((pc ^ (d & 15)) << 3))) = w;
                        asm volatile("" ::: "memory");
                    }
            }
        }
    }
};
}

struct Args { const float* in[17]; float* out; unsigned char* ws; int ph_lo, ph_hi; };

struct Frame {
    LAS unsigned char* lds;
    int wave, G, bid;
    unsigned char* ws;
};
#define FTID const int f_lane = lane_id(); const int f_tid = F.wave * 64 + f_lane; (void)f_tid

__device__ __forceinline__ void transpose_item(const float* W, int K, int N, bf16_t* WT, bool winperm, LAS float* scr, int item, int lane) {
    const int nblk = N / 32, kb = item / nblk, nb = item % nblk, k0 = 64 * kb, n0 = 32 * nb;
    float tv[32];
#pragma unroll
    for (int i = 0; i < 32; ++i) tv[i] = W[(size_t)(k0 + 2 * i + (lane >> 5)) * N + n0 + (lane & 31)];
#pragma unroll
    for (int i = 0; i < 32; ++i) scr[(2 * i + (lane >> 5)) * 33 + (lane & 31)] = tv[i];
    asm volatile("s_waitcnt lgkmcnt(0)" ::: "memory");
    int r0 = n0;
    if (winperm) { const int bj = n0 / FF, j = n0 % FF; r0 = 256 * (j / 128) + 128 * bj + (j % 128); }
    const int c = lane & 7;
#pragma unroll
    for (int j = 0; j < 4; ++j) { const int n = (lane >> 3) + 8 * j; const LAS float* s = scr + (8 * c) * 33 + n;
        u32x4 o; o.x = cvtpk(s[0 * 33], s[1 * 33]); o.y = cvtpk(s[2 * 33], s[3 * 33]); o.z = cvtpk(s[4 * 33], s[5 * 33]); o.w = cvtpk(s[6 * 33], s[7 * 33]);
        *(u32x4*)(WT + (size_t)(r0 + n) * K + k0 + 8 * c) = o; }
    asm volatile("s_waitcnt lgkmcnt(0)" ::: "memory");
}

__device__ __forceinline__ void phase0(Frame& F, const Args& a) {
    FTID;
    const int gw = F.bid * NWAVES + F.wave, NGW = F.G * NWAVES;
    {
        LAS float* scr = (LAS float*)(F.lds + F.wave * 8448);
        constexpr int I_IN = (D / 64) * (NIN / 32), I_OUT = (FF / 64) * (D / 32), I_KV = (D / 64) * (2 * D / 32), I_Q = (D / 64) * (D / 32), I_P = (256 / 64) * (256 / 32);
        constexpr int NITEMS = 4 * I_IN + 4 * I_OUT + I_KV + 2 * I_Q + 4 * I_P;
        const float* w_in = a.in[5]; const float* w_out = a.in[6]; const float* pool_w = a.in[7]; const float* w_kv = a.in[12]; const float* w_q = a.in[14]; const float* w_o = a.in[16];
        bf16_t* WIN = (bf16_t*)(F.ws + WS_WIN); bf16_t* WOUT = (bf16_t*)(F.ws + WS_WOUT); bf16_t* WKV = (bf16_t*)(F.ws + WS_WKV); bf16_t* WQ = (bf16_t*)(F.ws + WS_WQ); bf16_t* WO = (bf16_t*)(F.ws + WS_WO); bf16_t* WP = (bf16_t*)(F.ws + WS_WPOOL);
        for (int it = gw; it < NITEMS; it += NGW) {
            int r = it;
            if (r < 4 * I_IN) { const int f = r / I_IN; transpose_item(w_in + (size_t)f * D * NIN, D, NIN, WIN + (size_t)f * NIN * D, true, scr, r % I_IN, f_lane); continue; } r -= 4 * I_IN;
            if (r < 4 * I_OUT) { const int f = r / I_OUT; transpose_item(w_out + (size_t)f * FF * D, FF, D, WOUT + (size_t)f * D * FF, false, scr, r % I_OUT, f_lane); continue; } r -= 4 * I_OUT;
            if (r < I_KV) { transpose_item(w_kv, D, 2 * D, WKV, false, scr, r, f_lane); continue; } r -= I_KV;
            if (r < I_Q) { transpose_item(w_q, D, D, WQ, false, scr, r, f_lane); continue; } r -= I_Q;
            if (r < I_Q) { transpose_item(w_o, D, D, WO, false, scr, r, f_lane); continue; } r -= I_Q;
            { const int gi = r / I_P; transpose_item(pool_w + (size_t)gi * 65536, 256, 256, WP + (size_t)gi * 65536, false, scr, r % I_P, f_lane); }
        }
    }
    __syncthreads();
    {
        LAS float* cs = (LAS float*)(F.lds + 81920);
        const float* c = a.in[1];
        for (int i = f_tid; i < 2 * D; i += 512) { const float v = c[i]; cs[i] = v / (1.0f + __expf(-v)); }
        __syncthreads();
        const float* ada_w = a.in[2]; const float* kv_ada_w = a.in[10];
        float* MODP = (float*)(F.ws + WS_MODP);
        constexpr int NCC = NMODCOL / 512;
        for (int un = F.bid; un < NCC * KSPLIT; un += F.G) {
            const int cc = un % NCC, ks = un / NCC, n = cc * 512 + f_tid;
            const float* wp; int ldw;
            if (n < 9 * D) { wp = ada_w + n; ldw = 9 * D; } else if (n < 18 * D) { wp = ada_w + (size_t)D * 9 * D + (n - 9 * D); ldw = 9 * D; } else { wp = kv_ada_w + (n - 18 * D); ldw = 2 * D; }
            float a0 = 0.f, a1 = 0.f;
            const int k0 = ks * (D / KSPLIT);
#pragma unroll 32
            for (int k = 0; k < D / KSPLIT; ++k) { const float w = wp[(size_t)(k0 + k) * ldw]; a0 += cs[k0 + k] * w; a1 += cs[D + k0 + k] * w; }
            MODP[(size_t)(ks * 2 + 0) * NMODCOL + n] = a0; MODP[(size_t)(ks * 2 + 1) * NMODCOL + n] = a1;
        }
    }
    {
        f32x2_t* ROPE = (f32x2_t*)(F.ws + WS_ROPE);
        for (int idx = F.bid * 512 + f_tid; idx < T * 64; idx += F.G * 512) {
            const int pos = idx >> 6, i = idx & 63;
            double inv = 1.0, rr = 0.8659643233600653;
#pragma unroll
            for (int k = 0; k < 6; ++k) { if ((i >> k) & 1) inv *= rr; rr *= rr; }
            const double th2 = inv * inv; double cc = 1.0, ss = 1.0;
#pragma unroll
            for (int k = 11; k >= 1; --k) { cc = 1.0 - th2 * (1.0 / (double)((2 * k - 1) * (2 * k))) * cc; ss = 1.0 - th2 * (1.0 / (double)((2 * k) * (2 * k + 1))) * ss; }
            double ck = cc, sk = inv * ss, C = 1.0, S = 0.0;
#pragma unroll
            for (int k = 0; k < 14; ++k) { if ((pos >> k) & 1) { const double nc = C * ck - S * sk, ns = S * ck + C * sk; C = nc; S = ns; } const double c2 = ck * ck - sk * sk, s2 = 2.0 * sk * ck; ck = c2; sk = s2; }
            ROPE[idx] = (f32x2_t){(float)C, (float)S};
        }
    }
}

__device__ __forceinline__ void phase1(Frame& F, const Args& a) {
    FTID;
    const float* MODP = (const float*)(F.ws + WS_MODP); float* VEC = (float*)(F.ws + WS_VEC);
    const float* ada_b = a.in[3]; const float* norm_g = a.in[4]; const float* pool_scale = a.in[8]; const float* kv_norm = a.in[9]; const float* kv_ada_b = a.in[11];
    for (int gi = F.bid * 512 + f_tid; gi < 2 * NMODCOL; gi += F.G * 512) {
        const int b = gi / NMODCOL, n = gi % NMODCOL;
        float v = 0.f;
#pragma unroll
        for (int ks = 0; ks < KSPLIT; ++ks) v += MODP[(size_t)(ks * 2 + b) * NMODCOL + n];
        if (n < 18 * D) {
            const int l = n / (9 * D), nn = n % (9 * D), ch = nn / D, k = nn % D, s = ch / 3, role = ch % 3, sub = 3 * l + s;
            v += ada_b[l * 9 * D + nn];
            if (role == 0) VEC[((1 * 7 + sub) * 2 + b) * D + k] = v;
            else if (role == 1) VEC[((0 * 7 + sub) * 2 + b) * D + k] = norm_g[(l * 3 + s) * D + k] * (1.0f + v);
            else VEC[((2 * 7 + sub) * 2 + b) * D + k] = (s == 1 ? 1.0f : 0.5f) * (1.0f + v) * (sub == 1 ? pool_scale[k] : 1.0f);
        } else {
            const int nn = n - 18 * D; v += kv_ada_b[nn];
            if (nn < D) VEC[((1 * 7 + 6) * 2 + b) * D + nn] = v; else VEC[((0 * 7 + 6) * 2 + b) * D + (nn - D)] = kv_norm[nn - D] * (1.0f + v);
        }
    }
    if (F.bid == 0 && f_tid == 0) {
        const float* kn = a.in[13]; const float* qn = a.in[15]; float mq = 0.f, mk = 0.f;
        for (int i = 0; i < HD; ++i) { mq = fmaxf(mq, fabsf(qn[i])); mk = fmaxf(mk, fabsf(kn[i])); }
        *(float*)(F.ws + WS_CREF) = 11.313708498984761f * mq * mk * 1.4426950408889634f;
    }
}

__device__ __forceinline__ void phase2(Frame& F, const Args& a) {
    FTID;
    const int gw = F.bid * NWAVES + F.wave, NGW = F.G * NWAVES;
    const float* VEC = (const float*)(F.ws + WS_VEC); float* BIAS = (float*)(F.ws + WS_BIAS);
    constexpr int NROWS = 4 * NIN + 2 * D + D;
    for (int r = 4 * gw; r < NROWS; r += 4 * NGW) {
        const bf16_t* wrow; int sub; float* o0; float* o1;
        if (r < 4 * NIN) { const int f = r / NIN, n = r % NIN; wrow = (const bf16_t*)(F.ws + WS_WIN) + ((size_t)f * NIN + n) * D; sub = (f == 0) ? 0 : (f == 1) ? 2 : (f == 2) ? 3 : 5; o0 = BIAS + (f * 2 + 0) * NIN + n; o1 = BIAS + (f * 2 + 1) * NIN + n; }
        else if (r < 4 * NIN + 2 * D) { const int n = r - 4 * NIN; wrow = (const bf16_t*)(F.ws + WS_WKV) + (size_t)n * D; sub = 6; o0 = BIAS + 8 * NIN + n; o1 = BIAS + 8 * NIN + 2 * D + n; }
        else { const int n = r - 4 * NIN - 2 * D; wrow = (const bf16_t*)(F.ws + WS_WQ) + (size_t)n * D; sub = 4; o0 = BIAS + 8 * NIN + 4 * D + n; o1 = BIAS + 8 * NIN + 4 * D + D + n; }
        u32x4 w0[4], w1[4];
#pragma unroll
        for (int q = 0; q < 4; ++q) { w0[q] = *(const u32x4*)(wrow + (size_t)q * D + f_lane * 16); w1[q] = *(const u32x4*)(wrow + (size_t)q * D + f_lane * 16 + 8); }
        const float* s0 = VEC + ((1 * 7 + sub) * 2 + 0) * D + f_lane * 16; const float* s1 = s0 + D;
        f32x4 p[4], q4[4];
#pragma unroll
        for (int j = 0; j < 4; ++j) { p[j] = *(const f32x4*)(s0 + 4 * j); q4[j] = *(const f32x4*)(s1 + 4 * j); }
        float a0[4], a1[4];
#pragma unroll
        for (int q = 0; q < 4; ++q) {
            float wv[16];
            wv[0] = bflo(w0[q].x); wv[1] = bfhi(w0[q].x); wv[2] = bflo(w0[q].y); wv[3] = bfhi(w0[q].y); wv[4] = bflo(w0[q].z); wv[5] = bfhi(w0[q].z); wv[6] = bflo(w0[q].w); wv[7] = bfhi(w0[q].w);
            wv[8] = bflo(w1[q].x); wv[9] = bfhi(w1[q].x); wv[10] = bflo(w1[q].y); wv[11] = bfhi(w1[q].y); wv[12] = bflo(w1[q].z); wv[13] = bfhi(w1[q].z); wv[14] = bflo(w1[q].w); wv[15] = bfhi(w1[q].w);
            float x0 = 0.f, x1 = 0.f;
#pragma unroll
            for (int j = 0; j < 4; ++j)
#pragma unroll
                for (int e = 0; e < 4; ++e) { x0 += p[j][e] * wv[4 * j + e]; x1 += q4[j][e] * wv[4 * j + e]; }
            a0[q] = x0; a1[q] = x1;
        }
#pragma unroll
        for (int o = 1; o < 64; o <<= 1) {
#pragma unroll
            for (int q = 0; q < 4; ++q) { a0[q] += __shfl_xor(a0[q], o); a1[q] += __shfl_xor(a1[q], o); } }
        if (f_lane == 0) {
#pragma unroll
            for (int q = 0; q < 4; ++q) { o0[q] = a0[q]; o1[q] = a1[q]; } }
    }
    const float* x = a.in[0]; bf16_t* XB = (bf16_t*)(F.ws + WS_XB); float* SSQ = (float*)(F.ws + WS_SSQA);
#pragma unroll 2
    for (int m = gw; m < M; m += NGW) {
        const int b = m >= T ? 1 : 0;
        const f32x4* xr = (const f32x4*)(x + (size_t)m * D) + f_lane; const f32x4* wk = (const f32x4*)(VEC + ((0 * 7 + 0) * 2 + b) * D) + f_lane;
        f32x4 v[4]; float s = 0.f;
#pragma unroll
        for (int j = 0; j < 4; ++j) { v[j] = xr[64 * j]; s += (v[j][0] * v[j][0] + v[j][1] * v[j][1]) + (v[j][2] * v[j][2] + v[j][3] * v[j][3]); }
        s = wave_sum(s);
        u32x2* o8 = (u32x2*)(XB + (size_t)m * D) + f_lane;
#pragma unroll
        for (int j = 0; j < 4; ++j) { const f32x4 w = wk[64 * j]; u32x2 o; o.x = cvtpk(v[j][0] * w[0], v[j][1] * w[1]); o.y = cvtpk(v[j][2] * w[2], v[j][3] * w[3]); o8[64 * j] = o; }
        if (f_lane < 4) SSQ[(size_t)m * 4 + f_lane] = (f_lane == 0) ? s : 0.f;
    }
}

__device__ __forceinline__ void phase_pool_elem(Frame& F, const bf16_t* x, const float* ssq) {
    FTID;
    const float* VEC = (const float*)(F.ws + WS_VEC); bf16_t* OUT = (bf16_t*)(F.ws + WS_XB2);
    LAS float* rsl = (LAS float*)F.lds;
    const int gi = F.wave >> 1, w = 2 << gi;
    const int tq = (f_tid >> 5) & 3, c = 8 * ((f_tid & 31) | (gi << 5));
    for (int un = F.bid; un < M / 64; un += F.G) {
        const int m0 = un * 64, b = m0 >= T ? 1 : 0, bstart = b * T;
        __syncthreads();
        if (f_tid < 79) { const int tok = m0 - 15 + f_tid; rsl[f_tid] = (tok >= bstart) ? rstd_of(ssq + (size_t)tok * 4) : 0.f; }
        __syncthreads();
        const f32x4 wk0 = *(const f32x4*)(VEC + ((0 * 7 + 1) * 2 + b) * D + c), wk1 = *(const f32x4*)(VEC + ((0 * 7 + 1) * 2 + b) * D + c + 4);
        const int t0 = m0 + 16 * tq;
        f32x4 sa = {0.f, 0.f, 0.f, 0.f}, sb = {0.f, 0.f, 0.f, 0.f};
#define POOL_UNPK(h_, r_, a_, b_) do { a_ = (f32x4){bflo(h_.x), bfhi(h_.x), bflo(h_.y), bfhi(h_.y)} * (r_); b_ = (f32x4){bflo(h_.z), bfhi(h_.z), bflo(h_.w), bfhi(h_.w)} * (r_); } while (0)
#pragma nounroll
        for (int sx = t0 - w + 1; sx < t0; ++sx) if (sx >= bstart) { const u32x4 h = *(const u32x4*)(x + (size_t)sx * D + c); f32x4 a, bb; POOL_UNPK(h, rsl[sx - m0 + 15], a, bb); sa += a; sb += bb; }
#pragma unroll 8
        for (int t = t0; t < t0 + 16; ++t) {
            const u32x4 h = *(const u32x4*)(x + (size_t)t * D + c); f32x4 xa, xb_; POOL_UNPK(h, rsl[t - m0 + 15], xa, xb_);
            sa += xa; sb += xb_;
            const int tb = t - bstart; const float ic = 1.0f / (float)(tb + 1 < w ? tb + 1 : w);
            const f32x4 oa = wk0 * (sa * ic - xa), ob = wk1 * (sb * ic - xb_);
            u32x4 o; o.x = cvtpk(oa[0], oa[1]); o.y = cvtpk(oa[2], oa[3]); o.z = cvtpk(ob[0], ob[1]); o.w = cvtpk(ob[2], ob[3]);
            *(u32x4*)(OUT + (size_t)t * D + c) = o;
            const int so = t - w + 1;
            if (so >= bstart) { const u32x4 ho = *(const u32x4*)(x + (size_t)so * D + c); f32x4 a, bb; POOL_UNPK(ho, rsl[so - m0 + 15], a, bb); sa -= a; sb -= bb; }
        }
#undef POOL_UNPK
    }
}

__device__ __forceinline__ int key_of_pos(int p) { return 128 * ((p & 7) >> 2) + 64 * (p >> 7) + 16 * (p & 3) + ((p >> 3) & 15); }
__device__ __forceinline__ int pos_of_krow(int R) { return (R & ~12) | ((R & 4) << 1) | ((R & 8) >> 1); }

__device__ __forceinline__ void phase_kvprep(Frame& F, const Args& a) {
    FTID;
    bf16_t* KN = (bf16_t*)(F.ws + WS_KN); float* KMEAN = (float*)(F.ws + WS_KMEAN); const f32x2_t* ROPE = (const f32x2_t*)(F.ws + WS_ROPE);
    const float* k_norm = a.in[13];
    LAS float* part = (LAS float*)F.lds;
    const int lane = f_lane, ch = lane & 15, rsub = lane >> 4;
    const f32x4 gk0 = *(const f32x4*)(k_norm + 8 * ch), gk1 = *(const f32x4*)(k_norm + 8 * ch + 4);
    const float sgn = (ch < 8) ? -1.0f : 1.0f;
    for (int it = F.bid; it < BATCH * NH * NBLK; it += F.G) {
        const int blk = it & (NBLK - 1);
        bf16_t* base = KN + (size_t)it * (BS * HD);
        u32x4 raw[8];
#pragma unroll
        for (int p = 0; p < 8; ++p) raw[p] = *(const u32x4*)(base + (size_t)(p * 32 + F.wave * 4 + rsub) * HD + 8 * ch);
        asm volatile("s_waitcnt vmcnt(0)" ::: "memory");
        __syncthreads();
        float cs8[8] = {0.f, 0.f, 0.f, 0.f, 0.f, 0.f, 0.f, 0.f};
#pragma unroll
        for (int p = 0; p < 8; ++p) {
            const int row = p * 32 + F.wave * 4 + rsub, pos = blk * BS + row;
            const f32x4* rt = (const f32x4*)(ROPE + (size_t)pos * 64 + 8 * (ch & 7));
            const f32x4 c0 = rt[0], c1 = rt[1], c2 = rt[2], c3 = rt[3];
            const u32x4 rw = raw[p];
            float x[8] = {bflo(rw.x), bfhi(rw.x), bflo(rw.y), bfhi(rw.y), bflo(rw.z), bfhi(rw.z), bflo(rw.w), bfhi(rw.w)};
            float ss = 0.f;
#pragma unroll
            for (int e = 0; e < 8; ++e) ss += x[e] * x[e];
            ss += __shfl_xor(ss, 1); ss += __shfl_xor(ss, 2); ss += __shfl_xor(ss, 4); ss += __shfl_xor(ss, 8);
            const float rs = __builtin_amdgcn_rsqf(ss * (1.0f / HD) + EPS);
            float y[8], py[8];
#pragma unroll
            for (int e = 0; e < 4; ++e) { y[e] = x[e] * rs * gk0[e]; y[4 + e] = x[4 + e] * rs * gk1[e]; }
#pragma unroll
            for (int e = 0; e < 8; ++e) py[e] = __shfl_xor(y[e], 8);
            const float cs_[8] = {c0[0], c0[2], c1[0], c1[2], c2[0], c2[2], c3[0], c3[2]}, sn_[8] = {c0[1], c0[3], c1[1], c1[3], c2[1], c2[3], c3[1], c3[3]};
            float o[8];
#pragma unroll
            for (int e = 0; e < 8; ++e) { o[e] = y[e] * cs_[e] + sgn * py[e] * sn_[e]; cs8[e] += o[e]; }
            u32x4 w; w.x = cvtpk(o[0], o[1]); w.y = cvtpk(o[2], o[3]); w.z = cvtpk(o[4], o[5]); w.w = cvtpk(o[6], o[7]);
            const int pp = 8 * (16 * ((row >> 6) & 1) + (row & 15)) + 4 * (row >> 7) + ((row >> 4) & 3);
            const int R = (pp & ~12) | ((pp & 4) << 1) | ((pp & 8) >> 1);
            *(u32x4*)(base + (size_t)R * HD + ((ch ^ (R & 15)) << 3)) = w;
        }
#pragma unroll
        for (int e = 0; e < 8; ++e) { cs8[e] += __shfl_xor(cs8[e], 16); cs8[e] += __shfl_xor(cs8[e], 32); }
        if (rsub == 0) { *(LAS f32x4*)(part + F.wave * 128 + 8 * ch) = (f32x4){cs8[0], cs8[1], cs8[2], cs8[3]}; *(LAS f32x4*)(part + F.wave * 128 + 8 * ch + 4) = (f32x4){cs8[4], cs8[5], cs8[6], cs8[7]}; }
        __syncthreads();
        if (f_tid < 128) { float sm = 0.f;
#pragma unroll
            for (int wv = 0; wv < 8; ++wv) sm += part[wv * 128 + f_tid];
            KMEAN[(size_t)it * HD + f_tid] = sm * (1.0f / BS); }
    }
    __syncthreads();
}

__device__ __forceinline__ void phase_sel(Frame& F, const Args& a) {
    FTID;
    bf16_t* QN = (bf16_t*)(F.ws + WS_QN); const float* KMEAN = (const float*)(F.ws + WS_KMEAN); const f32x2_t* ROPE = (const f32x2_t*)(F.ws + WS_ROPE);
    unsigned* CNT = (unsigned*)(F.ws + WS_CNT); unsigned short* LIST = (unsigned short*)(F.ws + WS_LIST);
    const float* q_norm = a.in[15];
    LAS unsigned char* QT = F.lds;
    LAS unsigned char* KMH = F.lds + 65536;
    LAS unsigned char* KML = F.lds + 81920;
    LAS unsigned* hist = (LAS unsigned*)(F.lds + 98304);
    const int lane = f_lane, ch = lane & 15, rsub = lane >> 4;
    const f32x4 gq0 = *(const f32x4*)(q_norm + 8 * ch), gq1 = *(const f32x4*)(q_norm + 8 * ch + 4);
    const float sgn = (ch < 8) ? -1.0f : 1.0f;
    for (int it = F.bid; it < BATCH * NH * NBLK; it += F.G) {
        const int bh = it >> 6; int n = it & 63; { const int rr = (bh >> 2) & 3; if (rr & 2) n ^= 32; if (rr & 1) n = 63 - n; }
        __syncthreads();
        if (f_tid < 64) hist[f_tid] = 0u;
#pragma unroll
        for (int k2 = 0; k2 < 2; ++k2) {
            const int cidx = f_tid + 512 * k2, j = cidx >> 4, c = cidx & 15;
            u32x4 hw = {0u, 0u, 0u, 0u}, lw = {0u, 0u, 0u, 0u};
            if (j < n) { const float* kp = KMEAN + ((size_t)bh * NBLK + j) * HD + 8 * c; const f32x4 v0 = *(const f32x4*)kp, v1 = *(const f32x4*)(kp + 4);
                hw.x = cvtpk(v0[0], v0[1]); hw.y = cvtpk(v0[2], v0[3]); hw.z = cvtpk(v1[0], v1[1]); hw.w = cvtpk(v1[2], v1[3]);
                lw.x = cvtpk(v0[0] - bflo(hw.x), v0[1] - bfhi(hw.x)); lw.y = cvtpk(v0[2] - bflo(hw.y), v0[3] - bfhi(hw.y));
                lw.z = cvtpk(v1[0] - bflo(hw.z), v1[1] - bfhi(hw.z)); lw.w = cvtpk(v1[2] - bflo(hw.w), v1[3] - bfhi(hw.w)); }
            *(LAS u32x4*)(KMH + j * 256 + ((c ^ (j & 15)) << 4)) = hw; *(LAS u32x4*)(KML + j * 256 + ((c ^ (j & 15)) << 4)) = lw;
        }
#pragma unroll 2
        for (int p = 0; p < 8; ++p) {
            const int row = p * 32 + F.wave * 4 + rsub, t = n * BS + row;
            bf16_t* rp = QN + ((size_t)bh * T + t) * HD + 8 * ch;
            const u32x4 raw = *(const u32x4*)rp;
            const f32x4* rt = (const f32x4*)(ROPE + (size_t)t * 64 + 8 * (ch & 7));
            const f32x4 c0 = rt[0], c1 = rt[1], c2 = rt[2], c3 = rt[3];
            float x[8] = {bflo(raw.x), bfhi(raw.x), bflo(raw.y), bfhi(raw.y), bflo(raw.z), bfhi(raw.z), bflo(raw.w), bfhi(raw.w)};
            float ss = 0.f;
#pragma unroll
            for (int e = 0; e < 8; ++e) ss += x[e] * x[e];
            ss += __shfl_xor(ss, 1); ss += __shfl_xor(ss, 2); ss += __shfl_xor(ss, 4); ss += __shfl_xor(ss, 8);
            const float rs = __builtin_amdgcn_rsqf(ss * (1.0f / HD) + EPS);
            float y[8], py[8];
#pragma unroll
            for (int e = 0; e < 4; ++e) { y[e] = x[e] * rs * gq0[e]; y[4 + e] = x[4 + e] * rs * gq1[e]; }
#pragma unroll
            for (int e = 0; e < 8; ++e) py[e] = __shfl_xor(y[e], 8);
            const float cs_[8] = {c0[0], c0[2], c1[0], c1[2], c2[0], c2[2], c3[0], c3[2]}, sn_[8] = {c0[1], c0[3], c1[1], c1[3], c2[1], c2[3], c3[1], c3[3]};
            float o[8];
#pragma unroll
            for (int e = 0; e < 8; ++e) o[e] = y[e] * cs_[e] + sgn * py[e] * sn_[e];
            u32x4 w; w.x = cvtpk(o[0], o[1]); w.y = cvtpk(o[2], o[3]); w.z = cvtpk(o[4], o[5]); w.w = cvtpk(o[6], o[7]);
            *(u32x4*)rp = w;
            *(LAS u32x4*)(QT + row * 256 + ((ch ^ (row & 15)) << 4)) = w;
        }
        __syncthreads();
        const int q = lane & 31, hi = lane >> 5, sw = q & 15, qrow = 32 * F.wave + q;
        bf16x8 qf[8];
#pragma unroll
        for (int d0 = 0; d0 < 8; ++d0) qf[d0] = *(const LAS bf16x8*)(QT + qrow * 256 + (((2 * d0 + hi) ^ sw) << 4));
        float g0 = -INFINITY, g1 = -INFINITY, g2 = -INFINITY; int j0 = 0, j1 = 1, j2 = 2;
#define SEL_INS(gt_, jt_) do { const float gt = (gt_); const int jt = (jt_); \
            if (gt > g0 || (gt == g0 && jt < j0)) { g2 = g1; j2 = j1; g1 = g0; j1 = j0; g0 = gt; j0 = jt; } \
            else if (gt > g1 || (gt == g1 && jt < j1)) { g2 = g1; j2 = j1; g1 = gt; j1 = jt; } \
            else if (gt > g2 || (gt == g2 && jt < j2)) { g2 = gt; j2 = jt; } } while (0)
#pragma unroll
        for (int tau = 0; tau < 2; ++tau) {
            if (32 * tau < n) {
                f32x16 sacc = {};
                const LAS unsigned char* kh = KMH + (32 * tau + q) * 256; const LAS unsigned char* kl = KML + (32 * tau + q) * 256;
#pragma unroll
                for (int d0 = 0; d0 < 8; ++d0) {
                    const bf16x8 ah = *(const LAS bf16x8*)(kh + (((2 * d0 + hi) ^ sw) << 4)), al = *(const LAS bf16x8*)(kl + (((2 * d0 + hi) ^ sw) << 4));
                    sacc = __builtin_amdgcn_mfma_f32_32x32x16_bf16(ah, qf[d0], sacc, 0, 0, 0);
                    sacc = __builtin_amdgcn_mfma_f32_32x32x16_bf16(al, qf[d0], sacc, 0, 0, 0);
                }
#pragma unroll
                for (int r = 0; r < 16; ++r) { const int jb = 32 * tau + (r & 3) + 8 * (r >> 2) + 4 * hi; if (jb < n) SEL_INS(sacc[r], jb); }
            }
        }
        {
            const float pg0 = __shfl_xor(g0, 32), pg1 = __shfl_xor(g1, 32), pg2 = __shfl_xor(g2, 32);
            const int pj0 = __shfl_xor(j0, 32), pj1 = __shfl_xor(j1, 32), pj2 = __shfl_xor(j2, 32);
            if (pg0 > -INFINITY) SEL_INS(pg0, pj0);
            if (pg1 > -INFINITY) SEL_INS(pg1, pj1);
            if (pg2 > -INFINITY) SEL_INS(pg2, pj2);
        }
#undef SEL_INS
        const int t = n * BS + qrow;
        const int nsel = (hi == 0) ? (n < 3 ? n : 3) : 0;
        if (n < 3) { j0 = 0; j1 = 1; j2 = 2; }
        unsigned l0 = 0, l1 = 0, l2 = 0;
        if (nsel > 0) l0 = atomicAdd((unsigned*)&hist[j0], 1u);
        if (nsel > 1) l1 = atomicAdd((unsigned*)&hist[j1], 1u);
        if (nsel > 2) l2 = atomicAdd((unsigned*)&hist[j2], 1u);
        __syncthreads();
        if (f_tid < 64) { const unsigned c = hist[f_tid]; hist[64 + f_tid] = c ? atomicAdd(&CNT[bh * NBLK + f_tid], c) : 0u; }
        __syncthreads();
        unsigned short* lb = LIST + (size_t)bh * NBLK * T;
        if (nsel > 0) lb[(size_t)j0 * T + hist[64 + j0] + l0] = (unsigned short)((t << 2) | 0);
        if (nsel > 1) lb[(size_t)j1 * T + hist[64 + j1] + l1] = (unsigned short)((t << 2) | 1);
        if (nsel > 2) lb[(size_t)j2 * T + hist[64 + j2] + l2] = (unsigned short)((t << 2) | 2);
    }
    __syncthreads();
}

template <bool CAUSAL>
__device__ __forceinline__ void attn_qk(const LAS unsigned char* kl, const bf16x8 (&qf)[8], u32x4 (&pk)[8][2], float& lsum, int qrow, int lane, float c1, float c2) {
    const int i = lane & 31, hi = lane >> 5, sw = i & 15;
    int qr = qrow - hi; asm volatile("" : "+v"(qr));
#pragma unroll
    for (int tau = 0; tau < 8; ++tau) {
        f32x16 s = {};
        const LAS unsigned char* kp = kl + (32 * tau + i) * 256;
#pragma unroll
        for (int d0 = 0; d0 < 8; ++d0) { const bf16x8 kf = *(const LAS bf16x8*)(kp + (((2 * d0 + hi) ^ sw) << 4)); s = __builtin_amdgcn_mfma_f32_32x32x16_bf16(kf, qf[d0], s, 0, 0, 0); }
        float p[16];
#pragma unroll
        for (int r = 0; r < 16; ++r) {
            float e = __builtin_amdgcn_exp2f(s[r] * c1 - c2);
            if (CAUSAL) { const int keyc = 128 * ((r >> 2) & 1) + 64 * (tau >> 2) + 16 * (r & 3) + 4 * (tau & 3) + 2 * (r >> 3);
                e = __uint_as_float(__float_as_uint(e) & ~(unsigned)((qr - keyc) >> 31)); }
            p[r] = e; lsum += e;
        }
        pk[tau][0].x = cvtpk(p[0], p[1]); pk[tau][0].y = cvtpk(p[2], p[3]); pk[tau][0].z = cvtpk(p[4], p[5]); pk[tau][0].w = cvtpk(p[6], p[7]);
        pk[tau][1].x = cvtpk(p[8], p[9]); pk[tau][1].y = cvtpk(p[10], p[11]); pk[tau][1].z = cvtpk(p[12], p[13]); pk[tau][1].w = cvtpk(p[14], p[15]);
    }
}
__device__ __forceinline__ void attn_pv(const LAS unsigned char* vl, const u32x4 (&pk)[8][2], f32x16 (&o)[4], int lane) {
    const int i = lane & 31, hi = lane >> 5, sw = i & 15;
#pragma unroll
    for (int tau = 0; tau < 8; ++tau) {
        const bf16x8 pa0 = __builtin_bit_cast(bf16x8, pk[tau][0]), pa1 = __builtin_bit_cast(bf16x8, pk[tau][1]);
#pragma unroll
        for (int d0 = 0; d0 < 4; ++d0) {
            const LAS unsigned char* vp = vl + (32 * d0 + i) * 512;
            const bf16x8 v0 = *(const LAS bf16x8*)(vp + (((4 * tau + hi) ^ sw) << 4)), v1 = *(const LAS bf16x8*)(vp + (((4 * tau + 2 + hi) ^ sw) << 4));
            o[d0] = __builtin_amdgcn_mfma_f32_32x32x16_bf16(v0, pa0, o[d0], 0, 0, 0);
            o[d0] = __builtin_amdgcn_mfma_f32_32x32x16_bf16(v1, pa1, o[d0], 0, 0, 0);
        }
    }
}
__device__ __forceinline__ void dma_image(LAS unsigned char* dst, const bf16_t* src, int wave, int lane) {
#pragma unroll
    for (int i = 0; i < 8; ++i)
        __builtin_amdgcn_global_load_lds((const unsigned*)((const char*)src + ((i * 8 + wave) * 1024 + lane * 16)), (LAS unsigned*)(dst + (i * 8 + wave) * 1024), 16, 0, 0);
}
#define VM_WAIT0() asm volatile("s_waitcnt vmcnt(0)" ::: "memory")


template <bool LANEMAJOR>
__device__ __forceinline__ void store_rows_staged(LAS unsigned char* stg, const f32x16 (&o)[4], float scale, long rowoff, int sel, bool valid, bf16_t* base0, bf16_t* base1, bf16_t* base2, int lane) {
    const int q = lane & 31, hi = lane >> 5;
    const int lo32 = (int)(unsigned)(rowoff & 0xffffffffl), hi32 = (int)(rowoff >> 32);
    const int meta = valid ? sel : -1;
#pragma unroll
    for (int p = 0; p < 8; ++p) {
        if ((q >> 2) == p) {
            if (LANEMAJOR) {
                LAS unsigned char* wp = stg + (q & 3) * 272 + 128 * hi;
#pragma unroll
                for (int d0 = 0; d0 < 4; ++d0)
#pragma unroll
                    for (int gp = 0; gp < 2; ++gp) { u32x4 w; w.x = cvtpk(o[d0][8 * gp] * scale, o[d0][8 * gp + 1] * scale); w.y = cvtpk(o[d0][8 * gp + 2] * scale, o[d0][8 * gp + 3] * scale);
                        w.z = cvtpk(o[d0][8 * gp + 4] * scale, o[d0][8 * gp + 5] * scale); w.w = cvtpk(o[d0][8 * gp + 6] * scale, o[d0][8 * gp + 7] * scale); *(LAS u32x4*)(wp + 32 * d0 + 16 * gp) = w; }
            } else {
            LAS unsigned char* wp = stg + (q & 3) * 272 + 8 * hi;
#pragma unroll
            for (int d0 = 0; d0 < 4; ++d0)
#pragma unroll
                for (int g = 0; g < 4; ++g) { u32x2 w; w.x = cvtpk(o[d0][4 * g] * scale, o[d0][4 * g + 1] * scale); w.y = cvtpk(o[d0][4 * g + 2] * scale, o[d0][4 * g + 3] * scale); *(LAS u32x2*)(wp + 64 * d0 + 16 * g) = w; }
            }
        }
        asm volatile("s_waitcnt lgkmcnt(0)" ::: "memory");
        const int src = 4 * p + (lane >> 4);
        const int m_ = __shfl(meta, src), l_ = __shfl(lo32, src), h_ = __shfl(hi32, src);
        const u32x4 v = *(const LAS u32x4*)(stg + (lane >> 4) * 272 + (lane & 15) * 16);
        asm volatile("s_waitcnt lgkmcnt(0)" ::: "memory");
        if (m_ >= 0) {
            bf16_t* bp = (m_ == 0) ? base0 : (m_ == 1) ? base1 : base2;
            const long ro = ((long)h_ << 32) | (long)(unsigned)l_;
            *(u32x4*)(bp + ro + (lane & 15) * 8) = v;
        }
    }
}

template <int VAR>
__device__ __forceinline__ void phase_part1(Frame& F, int b) {
    FTID;
    const bf16_t* KN = (const bf16_t*)(F.ws + WS_KN) + (size_t)b * NH * NBLK * (BS * HD); const bf16_t* VT = (const bf16_t*)(F.ws + WS_VT) + (size_t)b * NH * NBLK * (BS * HD);
    const bf16_t* QN = (const bf16_t*)(F.ws + WS_QN) + (size_t)b * NH * T * HD;
    const unsigned* CNT = (const unsigned*)(F.ws + WS_CNT) + b * NH * NBLK; const unsigned short* LIST = (const unsigned short*)(F.ws + WS_LIST) + (size_t)b * NH * NBLK * T;
    float* LS = (float*)(F.ws + WS_LS);
    LAS int* pref = (LAS int*)(F.lds + 131072);
    LAS int* cnl = (LAS int*)(F.lds + 131072 + 2064);
    LAS int* ncs = (LAS int*)(F.lds + 131072 + 4160);
    LAS unsigned char* stg = F.lds + 131072 + 4160 + F.wave * 1088;
    const float c1 = 0.08838834764831845f * 1.4426950408889634f, c2 = *(const float*)(F.ws + WS_CREF);
    __syncthreads();
    { const unsigned c = CNT[f_tid]; cnl[f_tid] = (int)c; ncs[f_tid] = (int)((c + 255u) >> 8); }
    __syncthreads();
    { int s = 0; for (int i = 0; i < f_tid; ++i) s += ncs[i]; pref[f_tid] = s; if (f_tid == 511) pref[512] = s + ncs[511]; }
    __syncthreads();
    const int total = pref[512];
    const int lane = f_lane, q = lane & 31, hi = lane >> 5;
#define P1_FIND(it_, hj_, ch_) do { int lo_ = 0, hi2_ = 511; while (lo_ < hi2_) { const int mid_ = (lo_ + hi2_ + 1) >> 1; if (pref[mid_] <= (it_)) lo_ = mid_; else hi2_ = mid_ - 1; } hj_ = lo_; ch_ = (it_) - pref[lo_]; } while (0)
    const int vcu = ((F.G & 7) == 0) ? (F.bid & 7) * (F.G >> 3) + (F.bid >> 3) : F.bid;
    int it = (int)(((long)total * vcu) / F.G); const int it_end = (int)(((long)total * (vcu + 1)) / F.G);
    if (it >= it_end) return;
    int hj, ch; P1_FIND(it, hj, ch);
    bool newblk = true;
    dma_image(F.lds, KN + (size_t)hj * (BS * HD), F.wave, lane);
    bool valid; int t, r; bf16x8 qf[8];
    { const int li = ch * 256 + F.wave * 32 + q; valid = li < cnl[hj]; const unsigned e = valid ? LIST[(size_t)hj * T + li] : 0u; t = (int)(e >> 2); r = (int)(e & 3);
      const bf16_t* qp = QN + ((size_t)(hj >> 6) * T + t) * HD + 8 * hi;
#pragma unroll
      for (int d0 = 0; d0 < 8; ++d0) qf[d0] = *(const bf16x8*)(qp + 16 * d0); }
    for (;;) {
        const int itn = it + 1; const bool has_next = itn < it_end;
        int hjn = 0, chn = 0; if (has_next) P1_FIND(itn, hjn, chn);
        VM_WAIT0(); __syncthreads();
        if (newblk) dma_image(F.lds + 65536, VT + (size_t)hj * (BS * HD), F.wave, lane);
        bool validn = false; unsigned en = 0u;
        if (has_next) { const int li = chn * 256 + F.wave * 32 + q; validn = li < cnl[hjn]; en = validn ? LIST[(size_t)hjn * T + li] : 0u; }
        u32x4 pk[8][2]; float lsum = 0.f;
        if (VAR < 3) attn_qk<false>(F.lds, qf, pk, lsum, 0, lane, c1, c2);
        else {
#pragma unroll
            for (int a_ = 0; a_ < 8; ++a_) { pk[a_][0] = (u32x4){0u, 0u, 0u, 0u}; pk[a_][1] = (u32x4){0u, 0u, 0u, 0u}; } }
        lsum += __shfl_xor(lsum, 32);
        VM_WAIT0(); __syncthreads();
        const int tn = (int)(en >> 2), rn = (int)(en & 3);
        if (has_next) {
            if (hjn != hj) dma_image(F.lds, KN + (size_t)hjn * (BS * HD), F.wave, lane);
            const bf16_t* qp = QN + ((size_t)(hjn >> 6) * T + tn) * HD + 8 * hi;
#pragma unroll
            for (int d0 = 0; d0 < 8; ++d0) qf[d0] = *(const bf16x8*)(qp + 16 * d0);
        }
        f32x16 o[4]; o[0] = f32x16{}; o[1] = f32x16{}; o[2] = f32x16{}; o[3] = f32x16{};
        if (VAR < 2) attn_pv(F.lds + 65536, pk, o, lane);
        if (VAR < 1) {
            const int h = hj >> 6;
            store_rows_staged<true>(stg, o, 1.0f, ((long)h * T + t) * HD, r, valid, (bf16_t*)(F.ws + WS_XB2), (bf16_t*)(F.ws + WS_XB2 + 32 * MiB), (bf16_t*)(F.ws + WS_SLOT2), lane);
            if (valid && hi == 0) LS[((size_t)r * NH + h) * T + t] = lsum;
        }
        if (!has_next) break;
        newblk = (hjn != hj);
        it = itn; hj = hjn; ch = chn; valid = validn; t = tn; r = rn;
    }
    VM_WAIT0();
    __syncthreads();
#undef P1_FIND
}

__device__ __forceinline__ void phase_part2(Frame& F, int b) {
    FTID;
    const bf16_t* KN = (const bf16_t*)(F.ws + WS_KN) + (size_t)b * NH * NBLK * (BS * HD); const bf16_t* VT = (const bf16_t*)(F.ws + WS_VT) + (size_t)b * NH * NBLK * (BS * HD);
    const bf16_t* QN = (const bf16_t*)(F.ws + WS_QN) + (size_t)b * NH * T * HD;
    const float* LS = (const float*)(F.ws + WS_LS); bf16_t* ATT = (bf16_t*)(F.ws + WS_XB);
    const float c1 = 0.08838834764831845f * 1.4426950408889634f, c2 = *(const float*)(F.ws + WS_CREF);
    const int lane = f_lane, q = lane & 31, hi = lane >> 5;
    const int qrow = F.wave * 32 + q;
    int it = F.bid;
    if (it >= NH * NBLK) return;
    __syncthreads();
    dma_image(F.lds, KN + (size_t)it * (BS * HD), F.wave, lane);
    bf16x8 qf[8];
    { const bf16_t* qp = QN + ((size_t)(it >> 6) * T + (it & 63) * BS + qrow) * HD + 8 * hi;
#pragma unroll
      for (int d0 = 0; d0 < 8; ++d0) qf[d0] = *(const bf16x8*)(qp + 16 * d0); }
    for (;;) {
        const int itn = it + F.G; const bool has_next = itn < NH * NBLK;
        const int h = it >> 6, n = it & 63, t = n * BS + qrow;
        VM_WAIT0(); __syncthreads();
        dma_image(F.lds + 65536, VT + (size_t)it * (BS * HD), F.wave, lane);
        u32x4 pk[8][2]; float lsum = 0.f;
        attn_qk<true>(F.lds, qf, pk, lsum, qrow, lane, c1, c2);
        lsum += __shfl_xor(lsum, 32);
        VM_WAIT0(); __syncthreads();
        if (has_next) {
            dma_image(F.lds, KN + (size_t)itn * (BS * HD), F.wave, lane);
            const bf16_t* qp = QN + ((size_t)(itn >> 6) * T + (itn & 63) * BS + qrow) * HD + 8 * hi;
#pragma unroll
            for (int d0 = 0; d0 < 8; ++d0) qf[d0] = *(const bf16x8*)(qp + 16 * d0);
        }
        f32x16 o[4]; o[0] = f32x16{}; o[1] = f32x16{}; o[2] = f32x16{}; o[3] = f32x16{};
        attn_pv(F.lds + 65536, pk, o, lane);
        const int nsel = n < 3 ? n : 3;
        for (int r = 0; r < nsel; ++r) {
            const bf16_t* sp = (const bf16_t*)(F.ws + (r == 2 ? WS_SLOT2 : WS_XB2 + (size_t)r * 32 * MiB)) + ((size_t)h * T + t) * HD + 64 * hi;
            const float lr = LS[((size_t)r * NH + h) * T + t];
            u32x4 sw_[8];
#pragma unroll
            for (int c = 0; c < 8; ++c) sw_[c] = *(const u32x4*)(sp + 8 * c);
            lsum += lr;
#pragma unroll
            for (int d0 = 0; d0 < 4; ++d0)
#pragma unroll
                for (int gp = 0; gp < 2; ++gp) { const u32x4 w = sw_[2 * d0 + gp];
                    o[d0][8 * gp] += bflo(w.x); o[d0][8 * gp + 1] += bfhi(w.x); o[d0][8 * gp + 2] += bflo(w.y); o[d0][8 * gp + 3] += bfhi(w.y);
                    o[d0][8 * gp + 4] += bflo(w.z); o[d0][8 * gp + 5] += bfhi(w.z); o[d0][8 * gp + 6] += bflo(w.w); o[d0][8 * gp + 7] += bfhi(w.w); }
        }
        const float il = 1.0f / lsum;
        store_rows_staged<false>(F.lds + 131072 + 4160 + F.wave * 1088, o, il, ((long)(b * T + t)) * D + h * HD, 0, true, ATT, ATT, ATT, lane);
        if (!has_next) break;
        it = itn;
    }
    VM_WAIT0();
    __syncthreads();
}

#define XB_TMO      128
#define XB_XCNT(j)  (256  + 64 * (j))
#define XB_XSUB(j)  (1280 + 64 * (j))
#define XB_XGEN(j)  (2304 + 64 * (j))
#define XB_TOP      3328
#define XB_TOPGEN   3392
#define XCD_BAR_WORDS 3456
#define XB_SPIN_CAP (1u << 20)
__device__ __forceinline__ unsigned xb_ld(unsigned* p)              { return __hip_atomic_load(p, __ATOMIC_RELAXED, __HIP_MEMORY_SCOPE_AGENT); }
__device__ __forceinline__ unsigned xb_add(unsigned* p, unsigned v) { return __hip_atomic_fetch_add(p, v, __ATOMIC_RELAXED, __HIP_MEMORY_SCOPE_AGENT); }
__device__ __forceinline__ unsigned xb_xcc_id() { return (unsigned)__builtin_amdgcn_s_getreg((3 << 11) | 20) & 0xFu; }
#define XB_SPIN(cond, bar) do { unsigned _sp = 0; while (cond) { __builtin_amdgcn_s_sleep(1); \
    if ((++_sp & 255u) == 0u) { if (xb_ld(&(bar)[XB_TMO])) break; if (_sp > XB_SPIN_CAP) { atomicAdd(&(bar)[XB_TMO], 1u); break; } } } } while (0)
struct XcdBarrier { unsigned* bar; unsigned x; volatile LAS unsigned* st; };
__device__ __forceinline__ void xcd_barrier_complete(unsigned* bar, unsigned x, unsigned& nloc, unsigned& nx) {
    const unsigned G = gridDim.x;
    unsigned sum, cnt, mine, sp = 0u;
    for (;;) {
        sum = 0u; cnt = 0u; mine = 0u;
#pragma unroll
        for (unsigned j = 0; j < 16; ++j) { const unsigned c = xb_ld(&bar[XB_XCNT(j)]); sum += c; cnt += (c > 0u) ? 1u : 0u; mine = (j == x) ? c : mine; }
        if (sum == G) break;
        __builtin_amdgcn_s_sleep(1);
        if ((++sp & 255u) == 0u) { if (xb_ld(&bar[XB_TMO])) break; if (sp > XB_SPIN_CAP) { atomicAdd(&bar[XB_TMO], 1u); break; } }
    }
    nloc = mine > 0u ? mine : 1u; nx = cnt > 0u ? cnt : 1u;
}
__device__ __forceinline__ void xcd_barrier(const XcdBarrier& b, int tid) {
    asm volatile("s_waitcnt vmcnt(0)" ::: "memory");
    __syncthreads();
    if (tid == 0) {
        unsigned* bar = b.bar;
        __builtin_amdgcn_s_waitcnt(0);
        unsigned nloc = b.st[0], nx = b.st[1];
        if (nloc == 0u) { xcd_barrier_complete(bar, b.x, nloc, nx); b.st[0] = nloc; b.st[1] = nx; }
        const unsigned old = xb_add(&bar[XB_XSUB(b.x)], 1u);
        const unsigned gen = old / nloc;
        if (old + 1u == (gen + 1u) * nloc) {
            __builtin_amdgcn_fence(__ATOMIC_RELEASE, "agent");
            asm volatile("s_waitcnt vmcnt(0)" ::: "memory");
            const unsigned og = xb_add(&bar[XB_TOP], 1u);
            const unsigned tg = og / nx;
            if (og + 1u == (tg + 1u) * nx) xb_add(&bar[XB_TOPGEN], 1u);
            else XB_SPIN(xb_ld(&bar[XB_TOPGEN]) == tg, bar);
            __builtin_amdgcn_fence(__ATOMIC_ACQUIRE, "agent");
            xb_add(&bar[XB_XGEN(b.x)], 1u);
            asm volatile("s_waitcnt vmcnt(0)" ::: "memory");
        } else {
            XB_SPIN(xb_ld(&bar[XB_XGEN(b.x)]) == gen, bar);
            __builtin_amdgcn_fence(__ATOMIC_ACQUIRE, "agent");
            asm volatile("s_waitcnt vmcnt(0)" ::: "memory");
        }
    }
    __syncthreads();
}

__global__ void __launch_bounds__(512, 2) fwd_kernel(Args args) {
    extern __shared__ __attribute__((aligned(16))) unsigned char lds_raw[];
    Frame F;
    F.lds = (LAS unsigned char*)lds_raw;
    F.wave = __builtin_amdgcn_readfirstlane(threadIdx.x >> 6);
    F.G = gridDim.x; F.bid = blockIdx.x; F.ws = args.ws;
    unsigned char* ws = args.ws;
    const int lo = args.ph_lo, hi = args.ph_hi;
    XcdBarrier bar; bar.bar = (unsigned*)(ws + WS_BAR); bar.st = (volatile LAS unsigned*)(F.lds + LDS_BYTES - 64); bar.x = xb_xcc_id();
#if MK_COOP
    if (hi > NPH) cg::this_grid().sync();
    if (threadIdx.x == 0) { bar.st[0] = 0u; bar.st[1] = 0u; (void)xb_add(&bar.bar[XB_XCNT(bar.x)], 1u); }
#endif
    const float* VEC = (const float*)(ws + WS_VEC); const float* BIAS = (const float*)(ws + WS_BIAS);
    float* SSQA = (float*)(ws + WS_SSQA); float* SSQB = (float*)(ws + WS_SSQB);
    bf16_t* XB = (bf16_t*)(ws + WS_XB); bf16_t* XB2 = (bf16_t*)(ws + WS_XB2); bf16_t* ACT = (bf16_t*)(ws + WS_BIG);
    const bf16_t* WIN = (const bf16_t*)(ws + WS_WIN); const bf16_t* WOUT = (const bf16_t*)(ws + WS_WOUT);
    float* X = args.out;
    bf16_t* X16 = (bf16_t*)args.out;
    bf16_t* X5 = (bf16_t*)(ws + WS_SLOT2);
    LAS float* RED = (LAS float*)(F.lds + 131072 + 4096);
#define VWK(sub) (VEC + ((0 * 7 + (sub)) * 2) * D)
#define VGC(sub) (VEC + ((2 * 7 + (sub)) * 2) * D)
#if MK_COOP
#define SEAM(k) do { if ((k) + 1 < hi) xcd_barrier(bar, F.wave * 64 + lane_id()); } while (0)
#else
#define SEAM(k) do { } while (0)
#endif
#ifndef PHMASK
#define PHMASK 0xffffffffu
#endif
#define IN(k) (((PHMASK >> (k)) & 1u) && lo <= (k) && (k) < hi)
#define GEMM1(f, A_, ssq_) do { pg8::Gemm g{A_, WIN + (size_t)(f) * NIN * D, M, NIN, D, D, 0}; pg8::StaticOrder S; S.init(M, NIN, F.G, F.bid); \
        pg8::EpiSwiglu E{ACT, BIAS + (f) * 2 * NIN, ssq_}; pg8::gemm_phase(F.lds, g, S, E, F.wave); } while (0)
#define GEMM2(IN16_, OUT16_, f, xin_, xout_, sub_, xb1_, wk1_, xb2_, wk2_, ssq_) do { pg8::Gemm g{ACT, WOUT + (size_t)(f) * D * FF, M, D, FF, FF, 0}; pg8::StaticOrder S; S.init(M, D, F.G, F.bid, 1); \
        pg8::EpiResid<IN16_, OUT16_> E{xin_, xout_, VGC(sub_), xb1_, wk1_, xb2_, wk2_, ssq_, RED}; pg8::gemm_phase(F.lds, g, S, E, F.wave); } while (0)

#ifndef DUPMASK
#define DUPMASK 0u
#endif
#if MK_COOP
#define DUPBAR() xcd_barrier(bar, F.wave * 64 + lane_id())
#else
#define DUPBAR() do { } while (0)
#endif
#define PH(k, ...) if (IN(k)) { __VA_ARGS__; if ((DUPMASK >> (k)) & 1u) { DUPBAR(); __VA_ARGS__; } SEAM(k); }
    PH(0, phase0(F, args))
    PH(1, phase1(F, args))
    PH(2, phase2(F, args))
    PH(3, GEMM1(0, XB, SSQA))
    PH(4, GEMM2(false, true, 0, args.in[0], X16, 0, (bf16_t*)nullptr, (const float*)nullptr, (bf16_t*)nullptr, (const float*)nullptr, SSQB))
    PH(5, phase_pool_elem(F, X16, SSQB))
    PH(6, { pg8::Gemm g{XB2, (const bf16_t*)(ws + WS_WPOOL), M, D, 256, D, 256}; pg8::StaticOrder S; S.init(M, D, F.G, F.bid, 1);
        pg8::EpiResid<true, true> E{X16, X16, VGC(1), XB, VWK(2), (bf16_t*)nullptr, (const float*)nullptr, SSQA, RED}; pg8::gemm_phase(F.lds, g, S, E, F.wave); })
    PH(7, GEMM1(1, XB, SSQA))
    PH(8, GEMM2(true, true, 1, X16, X16, 2, XB, VWK(3), XB2, VWK(6), SSQB))
    PH(9, GEMM1(2, XB, SSQB))
    PH(10, GEMM2(true, true, 2, X16, X16, 3, XB, VWK(4), (bf16_t*)nullptr, (const float*)nullptr, SSQA))
    PH(11, {
        { pg8::Gemm g{XB, (const bf16_t*)(ws + WS_WQ), M, D, D, D, 0}; pg8::StaticOrder S; S.init(M, D, F.G, F.bid);
          pg8::EpiProj E{BIAS + 8 * NIN + 4 * D, D, SSQA, (bf16_t*)(ws + WS_QN), (bf16_t*)nullptr}; pg8::gemm_phase(F.lds, g, S, E, F.wave); }
        { pg8::Gemm g{XB2, (const bf16_t*)(ws + WS_WKV), M, 2 * D, D, D, 0}; pg8::StaticOrder S; S.init(M, 2 * D, F.G, F.bid);
          pg8::EpiProj E{BIAS + 8 * NIN, 2 * D, SSQB, (bf16_t*)(ws + WS_KN), (bf16_t*)(ws + WS_VT)}; pg8::gemm_phase(F.lds, g, S, E, F.wave); } })
#if defined(PROBE_KVPREP)
    PH(12, { phase_kvprep(F, args); DUPBAR();
        { pg8::Gemm g{XB2, (const bf16_t*)(ws + WS_WKV), M, 2 * D, D, D, 0}; pg8::StaticOrder S; S.init(M, 2 * D, F.G, F.bid);
          pg8::EpiProj E{BIAS + 8 * NIN, 2 * D, SSQB, (bf16_t*)(ws + WS_KN), (bf16_t*)(ws + WS_VT)}; pg8::gemm_phase(F.lds, g, S, E, F.wave); }
        DUPBAR(); phase_kvprep(F, args); })
#else
    PH(12, phase_kvprep(F, args))
#endif
    PH(13, phase_sel(F, args))
#ifndef P1VAR
#define P1VAR 0
#endif
    if (IN(14)) { phase_part1<0>(F, 0); if (P1VAR) { DUPBAR(); phase_part1<P1VAR>(F, 0); } SEAM(14); }
    PH(15, phase_part2(F, 0))
    PH(16, phase_part1<0>(F, 1))
    PH(17, phase_part2(F, 1))
    PH(18, { pg8::Gemm g{XB, (const bf16_t*)(ws + WS_WO), M, D, D, D, 0}; pg8::StaticOrder S; S.init(M, D, F.G, F.bid, 1);
        pg8::EpiResid<true, true> E{X16, X5, VGC(4), XB2, VWK(5), (bf16_t*)nullptr, (const float*)nullptr, SSQA, RED}; pg8::gemm_phase(F.lds, g, S, E, F.wave); })
    PH(19, GEMM1(3, XB2, SSQA))
    PH(20, GEMM2(true, false, 3, X5, X, 5, (bf16_t*)nullptr, (const float*)nullptr, (bf16_t*)nullptr, (const float*)nullptr, (float*)nullptr))
}

extern "C" void kernel_launch(void* const* d_in, const int* in_sizes, int n_in, void* d_out, int out_size, void* d_ws, size_t ws_size, hipStream_t stream) {
    static int grid = 0;
    if (grid == 0) {
        if (n_in != 17 || in_sizes[0] != M * D || out_size != M * D || ws_size < WS_END) { fprintf(stderr, "kernel_launch: unexpected shapes (n_in %d, in0 %d, out %d, ws %zu < %zu)\n", n_in, n_in > 0 ? in_sizes[0] : -1, out_size, ws_size, (size_t)WS_END); grid = -1; return; }
        int dev = 0, cus = 0, per_cu = 0;
        if (hipGetDevice(&dev) != hipSuccess || hipDeviceGetAttribute(&cus, hipDeviceAttributeMultiprocessorCount, dev) != hipSuccess) { grid = -1; return; }
        if (hipFuncSetAttribute((const void*)fwd_kernel, hipFuncAttributeMaxDynamicSharedMemorySize, LDS_BYTES) != hipSuccess) { fprintf(stderr, "kernel_launch: hipFuncSetAttribute failed\n"); grid = -1; return; }
        if (hipOccupancyMaxActiveBlocksPerMultiprocessor(&per_cu, (const void*)fwd_kernel, 512, LDS_BYTES) != hipSuccess || per_cu < 1) { fprintf(stderr, "kernel_launch: occupancy query says %d\n", per_cu); per_cu = 1; }
        (void)hipGetLastError();
        grid = cus * 1;
    }
    if (grid < 0) return;
    if (hipMemsetAsync(d_ws, 0, 65536, stream) != hipSuccess) { fprintf(stderr, "kernel_launch: memset failed\n"); return; }
    Args a{};
    for (int i = 0; i < 17; ++i) a.in[i] = (const float*)d_in[i];
    a.out = (float*)d_out; a.ws = (unsigned char*)d_ws;
#if MK_COOP
    a.ph_lo = 0; a.ph_hi = NPH;
    void* kargs[] = {&a};
    hipError_t e = hipLaunchCooperativeKernel((const void*)fwd_kernel, dim3(grid), dim3(512), kargs, LDS_BYTES, stream);
    if (e != hipSuccess) fprintf(stderr, "cooperative launch failed: %s (grid %d)\n", hipGetErrorString(e), grid);
#else
    for (int p = 0; p < NPH; ++p) { a.ph_lo = p; a.ph_hi = p + 1; hipLaunchKernelGGL(fwd_kernel, dim3(grid), dim3(512), LDS_BYTES, stream, a); }
#endif
}
```

```cpp
#include <hip/hip_runtime.h>
#include <hip/hip_cooperative_groups.h>
#include <cstdio>
#include <cstdint>
namespace cg = cooperative_groups;

#ifndef MK_COOP
#define MK_COOP 1
#endif

#define LAS __attribute__((address_space(3)))
typedef unsigned short bf16_t;
typedef short bf16x8 __attribute__((ext_vector_type(8)));
typedef float f32x4 __attribute__((ext_vector_type(4)));
typedef float f32x16 __attribute__((ext_vector_type(16)));
typedef unsigned u32x4 __attribute__((ext_vector_type(4)));
typedef unsigned u32x2 __attribute__((ext_vector_type(2)));
typedef float f32x2_t __attribute__((ext_vector_type(2)));
typedef __bf16 bf16x2_t __attribute__((ext_vector_type(2)));

constexpr int BATCH = 2, T = 16384, D = 1024, FF = 2816, NH = 8, HD = 128, NBLK = 64, BS = 256;
constexpr int M = BATCH * T;
constexpr int NIN = 2 * FF;
constexpr float EPS = 1e-6f;
constexpr int NMODCOL = 2 * 9 * D + 2 * D;
constexpr int KSPLIT = 16;

constexpr size_t MiB = 1u << 20;
constexpr size_t WS_CNT = 0;
constexpr size_t WS_BAR = 16384;
constexpr size_t WS_CREF = 8192;
constexpr size_t WS_MODP = 64 * 1024;
constexpr size_t WS_VEC = 3 * MiB;
constexpr size_t WS_BIAS = 3 * MiB + 256 * 1024;
constexpr size_t WS_KMEAN = 3 * MiB + 512 * 1024;
constexpr size_t WS_SSQA = 4 * MiB, WS_SSQB = 6 * MiB;
constexpr size_t WS_ROPE = 8 * MiB;
constexpr size_t WS_LS = 16 * MiB;
constexpr size_t WS_WIN = 20 * MiB;
constexpr size_t WS_WOUT = 64 * MiB;
constexpr size_t WS_WKV = 86 * MiB, WS_WQ = 90 * MiB, WS_WO = 92 * MiB, WS_WPOOL = 94 * MiB;
constexpr size_t WS_XB = 95 * MiB;
constexpr size_t WS_XB2 = 159 * MiB;
constexpr size_t WS_BIG = 223 * MiB;
constexpr size_t WS_KN = WS_BIG, WS_VT = WS_BIG + 64 * MiB, WS_QN = WS_BIG + 128 * MiB;
constexpr size_t WS_SLOT2 = WS_BIG + 192 * MiB;
constexpr size_t WS_LIST = WS_SLOT2 + 32 * MiB;
constexpr size_t WS_END = WS_LIST + 32 * MiB;
static_assert(WS_END <= 512 * MiB, "ws map");

constexpr int LDS_BYTES = 147456;
constexpr int NWAVES = 8;
constexpr int NPH = 21;

__device__ __forceinline__ int lane_id() { int l; asm volatile("v_mbcnt_lo_u32_b32 %0, -1, 0\n\tv_mbcnt_hi_u32_b32 %0, -1, %0" : "=v"(l)); return l; }
__device__ __forceinline__ unsigned cvtpk(float lo, float hi) { f32x2_t v = {lo, hi}; bf16x2_t b = __builtin_convertvector(v, bf16x2_t); return __builtin_bit_cast(unsigned, b); }
__device__ __forceinline__ float bflo(unsigned w) { return __uint_as_float(w << 16); }
__device__ __forceinline__ float bfhi(unsigned w) { return __uint_as_float(w & 0xffff0000u); }
__device__ __forceinline__ float wave_sum(float v) {
#pragma unroll
    for (int o = 1; o < 64; o <<= 1) v += __shfl_xor(v, o);
    return v;
}
__device__ __forceinline__ float rstd_from(const f32x4 a) { return __builtin_amdgcn_rsqf(((a[0] + a[1]) + (a[2] + a[3])) * (1.0f / D) + EPS); }
__device__ __forceinline__ float rstd_of(const float* p) { return rstd_from(*(const f32x4*)p); }
__device__ __forceinline__ float silu_mul(float g, float u) { return g * __builtin_amdgcn_rcpf(1.0f + __builtin_amdgcn_exp2f(-1.4426950408889634f * g)) * u; }

namespace pg8 {
constexpr int BM = 256, BK = 64, HALF = 128, HTB = HALF * BK * 2, STAGE_BYTES = 8 * HTB, NXCD = 8, WGM = 8;
__host__ __device__ __forceinline__ int lds_byte(int r, int c) { const int st = (r >> 4) * 2 + (c >> 5), rr = r & 15, cc = c & 31, ob = rr * 64 + cc * 2; return st * 1024 + (ob ^ (((ob >> 9) & 1) << 5)); }
__host__ __device__ __forceinline__ void stage_rc(int b, int& R, int& C) { const int st = b / 1024, sb = b % 1024, swz = sb ^ (((sb >> 9) & 1) << 5); R = (st >> 1) * 16 + swz / 64; C = (st & 1) * 32 + (swz % 64) / 2; }
__host__ __device__ __forceinline__ int perm32(int rho) { const int n = rho >> 4, i = rho & 15; return 8 * (i >> 2) + 4 * n + (i & 3); }

struct Unit { int pm, pn; };
struct Gemm { const bf16_t* A; const bf16_t* Bt; int M, N, K, lda, acol; };

struct StaticOrder {
    int nM, nN, nwg, G, c;
    __host__ __device__ __forceinline__ void init(int M_, int N_, int G_, int c_, int rev_ = 0) { nM = M_ / BM; nN = N_ / BM; nwg = nM * nN; G = G_; c = c_;
        if (rev_ && nwg == 2 * G_) { c = c_ + G_; G = -G_; } }
    __host__ __device__ __forceinline__ bool next(int i, Unit& u) const {
        const int L = i * G + c; if (L >= nwg || L < 0) return false;
        int wgid = (int)L; { const int q = nwg / NXCD, r = nwg % NXCD, xcd = wgid % NXCD, off = wgid / NXCD; wgid = (xcd < r ? xcd * (q + 1) : r * (q + 1) + (xcd - r) * q) + off; }
        const int nig = WGM * nN, gid = wgid / nig, fm = gid * WGM, gsz = (nM - fm) < WGM ? (nM - fm) : WGM;
        u.pm = fm + ((wgid % nig) % gsz); u.pn = (wgid % nig) / gsz; return true;
    }
};

template <class Epi>
__device__ __forceinline__ void gemm_phase(LAS unsigned char* lds, const Gemm g, const StaticOrder& S, const Epi& E, int wid) {
    const int lane = lane_id(), tid = wid * 64 + lane, wr = wid >> 2, wc = wid & 3, fr = lane & 15, fq = lane >> 4;
    const int K = g.K, nt = K / BK, lda = g.lda;
    unsigned voffA[2], voffB[2];
#pragma unroll
    for (int i = 0; i < 2; ++i) { int R, C; stage_rc(tid * 16 + i * 8192, R, C); const int Rb = (R & ~31) + perm32(R & 31);
        voffA[i] = (unsigned)(R * lda + C) * 2u; voffB[i] = (unsigned)(Rb * K + C) * 2u; }
    const size_t kstep = (size_t)(BK * 2);
    const size_t hstepA = (size_t)HALF * lda * 2, hstepB = (size_t)HALF * K * 2;
    const size_t tstepA = 2 * hstepA, tstepB = 2 * hstepB;
    const size_t acolb = (size_t)g.acol * 2;
    const unsigned ldsw = (unsigned)wid * 1024u;
    const int aoff = lds_byte(wr * 64 + fr, fq * 8), boff = lds_byte(wc * 32 + fr, fq * 8);
#define PG8_SA(b, h) (((b) * 2 + (h)) * HTB)
#define PG8_SB(b, h) ((4 + (b) * 2 + (h)) * HTB)
#define PG8_STAGE(bufoff, gbase, voff) do { _Pragma("unroll") for (int _i = 0; _i < 2; ++_i) \
        __builtin_amdgcn_global_load_lds((const unsigned*)((const char*)(gbase) + (voff)[_i]), (LAS unsigned*)(lds + (bufoff) + ldsw + _i * 8192), 16, 0, 0); } while (0)
#define PG8_LDA(dst, b, h) do { _Pragma("unroll") for (int m = 0; m < 4; ++m) _Pragma("unroll") for (int k = 0; k < 2; ++k) dst[m][k] = *(const LAS bf16x8*)(lds + PG8_SA(b, h) + aoff + m * 2048 + k * 1024); } while (0)
#define PG8_LDB(dst, b, h) do { _Pragma("unroll") for (int n = 0; n < 2; ++n) _Pragma("unroll") for (int k = 0; k < 2; ++k) dst[n][k] = *(const LAS bf16x8*)(lds + PG8_SB(b, h) + boff + n * 2048 + k * 1024); } while (0)
#define PG8_MMA(ai, bj, At, Bt) do { __builtin_amdgcn_s_setprio(1); _Pragma("unroll") for (int m = 0; m < 4; ++m) _Pragma("unroll") for (int n = 0; n < 2; ++n) _Pragma("unroll") for (int k = 0; k < 2; ++k) \
        acc[ai][bj][m][n] = __builtin_amdgcn_mfma_f32_16x16x32_bf16(Bt[n][k], At[m][k], acc[ai][bj][m][n], 0, 0, 0); __builtin_amdgcn_s_setprio(0); } while (0)
#define PG8_WAIT_V(n) asm volatile("s_waitcnt vmcnt(" #n ")" ::: "memory")
#define PG8_WAIT_L(n) asm volatile("s_waitcnt lgkmcnt(" #n ")" ::: "memory")
#define PG8_BAR __builtin_amdgcn_s_barrier()
#define PG8_SCHED __builtin_amdgcn_sched_barrier(0)
    Unit cur, nxt; int ui = 0;
    if (!S.next(0, cur)) return;
    f32x4 acc[2][2][4][2];
#pragma unroll
    for (int a = 0; a < 2; ++a)
#pragma unroll
        for (int b = 0; b < 2; ++b)
#pragma unroll
            for (int m = 0; m < 4; ++m)
#pragma unroll
                for (int n = 0; n < 2; ++n) acc[a][b][m][n] = (f32x4){0.f, 0.f, 0.f, 0.f};
    bf16x8 At[4][2], B0[2][2], B1[2][2];
    const char* cA = (const char*)g.A + (size_t)cur.pm * tstepA + (size_t)cur.pn * acolb; const char* cB = (const char*)g.Bt + (size_t)cur.pn * tstepB;
    PG8_STAGE(PG8_SB(0, 0), cB, voffB); PG8_STAGE(PG8_SB(0, 1), cB + hstepB, voffB); PG8_STAGE(PG8_SA(0, 0), cA, voffA); PG8_STAGE(PG8_SA(0, 1), cA + hstepA, voffA);
    if (wr == 1) PG8_BAR;
    PG8_WAIT_V(2); PG8_BAR;
    PG8_STAGE(PG8_SB(1, 0), cB + kstep, voffB); PG8_STAGE(PG8_SA(1, 0), cA + kstep, voffA); PG8_STAGE(PG8_SB(1, 1), cB + hstepB + kstep, voffB);
    PG8_WAIT_V(6); PG8_BAR;
    for (;;) {
        const bool has_next = S.next(ui + 1, nxt);
        const char* nA = has_next ? (const char*)g.A + (size_t)nxt.pm * tstepA + (size_t)nxt.pn * acolb : cA; const char* nB = has_next ? (const char*)g.Bt + (size_t)nxt.pn * tstepB : cB;
#pragma nounroll
        for (int t = 0; t < nt; t += 2) {
            const bool last = (t == nt - 2);
            const char* a1 = cA + (size_t)(t + 1) * kstep;
            const char* a2 = last ? nA : cA + (size_t)(t + 2) * kstep; const char* b2 = last ? nB : cB + (size_t)(t + 2) * kstep;
            const char* a3 = a2 + kstep; const char* b3 = b2 + kstep;
            PG8_LDB(B0, 0, 0); PG8_LDB(B1, 0, 1); PG8_SCHED; PG8_LDA(At, 0, 0); PG8_STAGE(PG8_SA(1, 1), a1 + hstepA, voffA);
            PG8_WAIT_V(8); PG8_WAIT_L(0); PG8_BAR; PG8_MMA(0, 0, At, B0); PG8_MMA(0, 1, At, B1); PG8_BAR; PG8_SCHED;
            PG8_LDA(At, 0, 1); PG8_STAGE(PG8_SB(0, 0), b2, voffB); PG8_STAGE(PG8_SB(0, 1), b2 + hstepB, voffB); PG8_STAGE(PG8_SA(0, 0), a2, voffA);
            PG8_WAIT_V(8); PG8_WAIT_L(0); PG8_BAR; PG8_MMA(1, 0, At, B0); PG8_MMA(1, 1, At, B1); PG8_BAR; PG8_SCHED;
            PG8_LDB(B0, 1, 0); PG8_LDB(B1, 1, 1); PG8_SCHED; PG8_LDA(At, 1, 0); PG8_STAGE(PG8_SA(0, 1), a2 + hstepA, voffA);
            PG8_WAIT_V(8); PG8_WAIT_L(0); PG8_BAR; PG8_MMA(0, 0, At, B0); PG8_MMA(0, 1, At, B1); PG8_BAR; PG8_SCHED;
            PG8_LDA(At, 1, 1); PG8_STAGE(PG8_SB(1, 0), b3, voffB); PG8_STAGE(PG8_SB(1, 1), b3 + hstepB, voffB); PG8_STAGE(PG8_SA(1, 0), a3, voffA);
            PG8_WAIT_V(8); PG8_WAIT_L(0); PG8_BAR; PG8_MMA(1, 0, At, B0); PG8_MMA(1, 1, At, B1); PG8_BAR; PG8_SCHED;
        }
        if (wr == 0) PG8_BAR;
        E(acc, cur, wr, wc, fr, fq);
        if (!has_next) break;
#pragma unroll
        for (int a = 0; a < 2; ++a)
#pragma unroll
            for (int b = 0; b < 2; ++b)
#pragma unroll
                for (int m = 0; m < 4; ++m)
#pragma unroll
                    for (int n = 0; n < 2; ++n) acc[a][b][m][n] = (f32x4){0.f, 0.f, 0.f, 0.f};
        cur = nxt; cA = nA; cB = nB; ++ui;
        if (wr == 1) PG8_BAR;
    }
    PG8_WAIT_V(0);
    PG8_BAR;
#undef PG8_SA
#undef PG8_SB
#undef PG8_STAGE
#undef PG8_LDA
#undef PG8_LDB
#undef PG8_MMA
#undef PG8_WAIT_V
#undef PG8_WAIT_L
#undef PG8_BAR
#undef PG8_SCHED
}

struct EpiSwiglu {
    bf16_t* O; const float* bias; const float* ssq;
    __device__ __forceinline__ void operator()(const f32x4 (&acc)[2][2][4][2], const Unit& u, int wr, int wc, int fr_, int fq_) const {
        int fr = fr_, fq = fq_; asm volatile("" : "+v"(fr), "+v"(fq));
        const int b = u.pm >= (T / BM) ? 1 : 0;
        const float* bp = bias + b * NIN + u.pn * 256 + wc * 32 + 8 * fq;
        const f32x4 bg0 = *(const f32x4*)bp, bg1 = *(const f32x4*)(bp + 4), bu0 = *(const f32x4*)(bp + 128), bu1 = *(const f32x4*)(bp + 132);
        f32x4 sq[2][4];
#pragma unroll
        for (int ai = 0; ai < 2; ++ai)
#pragma unroll
            for (int m = 0; m < 4; ++m) sq[ai][m] = *(const f32x4*)(ssq + (size_t)(u.pm * BM + ai * HALF + wr * 64 + m * 16 + fr) * 4);
#pragma unroll
        for (int ai = 0; ai < 2; ++ai)
#pragma unroll
            for (int m = 0; m < 4; ++m) {
                const int row = u.pm * BM + ai * HALF + wr * 64 + m * 16 + fr;
                const float rs = rstd_from(sq[ai][m]);
                const f32x4 g0 = acc[ai][0][m][0] * rs + bg0, g1 = acc[ai][0][m][1] * rs + bg1, u0 = acc[ai][1][m][0] * rs + bu0, u1 = acc[ai][1][m][1] * rs + bu1;
                const f32x4 a0 = g0 * -1.4426950408889634f, a1 = g1 * -1.4426950408889634f;
                f32x4 e0, e1;
#pragma unroll
                for (int i = 0; i < 4; ++i) { e0[i] = __builtin_amdgcn_exp2f(a0[i]); e1[i] = __builtin_amdgcn_exp2f(a1[i]); }
                e0 = e0 + 1.0f; e1 = e1 + 1.0f;
                f32x4 r0, r1;
#pragma unroll
                for (int i = 0; i < 4; ++i) { r0[i] = __builtin_amdgcn_rcpf(e0[i]); r1[i] = __builtin_amdgcn_rcpf(e1[i]); }
                const f32x4 o0 = (g0 * u0) * r0, o1 = (g1 * u1) * r1;
                u32x4 w;
                w.x = cvtpk(o0[0], o0[1]); w.y = cvtpk(o0[2], o0[3]); w.z = cvtpk(o1[0], o1[1]); w.w = cvtpk(o1[2], o1[3]);
                __builtin_nontemporal_store(w, (u32x4*)(O + (size_t)row * FF + u.pn * 128 + wc * 32 + 8 * fq));
            }
    }
};
template <bool IN16, bool OUT16>
struct EpiResid {
    const void* xin; void* xout; const float* gc; bf16_t* xb1; const float* wk1; bf16_t* xb2; const float* wk2; float* ssq; LAS float* red;
    __device__ __forceinline__ void operator()(const f32x4 (&acc)[2][2][4][2], const Unit& u, int wr, int wc, int fr_, int fq_) const {
        int fr = fr_, fq = fq_; asm volatile("" : "+v"(fr), "+v"(fq));
        const int b = u.pm >= (T / BM) ? 1 : 0;
        const int col0 = u.pn * 256 + wc * 32 + 8 * fq;
        f32x4 gv[2][2];
#pragma unroll
        for (int bj = 0; bj < 2; ++bj) { gv[bj][0] = *(const f32x4*)(gc + b * D + col0 + bj * HALF); gv[bj][1] = *(const f32x4*)(gc + b * D + col0 + bj * HALF + 4); }
#pragma unroll
        for (int ai = 0; ai < 2; ++ai)
#pragma unroll
            for (int mp = 0; mp < 4; mp += 2) {
                f32x4 xr[2][2][2]; u32x4 xh[2][2];
#pragma unroll
                for (int mm = 0; mm < 2; ++mm)
#pragma unroll
                    for (int bj = 0; bj < 2; ++bj) { const size_t off = (size_t)(u.pm * BM + ai * HALF + wr * 64 + (mp + mm) * 16 + fr) * D + col0 + bj * HALF;
                        if (IN16) xh[mm][bj] = *(const u32x4*)((const bf16_t*)xin + off);
                        else { xr[mm][bj][0] = *(const f32x4*)((const float*)xin + off); xr[mm][bj][1] = *(const f32x4*)((const float*)xin + off + 4); } }
#pragma unroll
                for (int mm = 0; mm < 2; ++mm) {
                    const int m = mp + mm, rl = ai * HALF + wr * 64 + m * 16 + fr, row = u.pm * BM + rl;
                    float s = 0.f;
#pragma unroll
                    for (int bj = 0; bj < 2; ++bj) {
                        const size_t off = (size_t)row * D + col0 + bj * HALF;
                        f32x4 x0, x1;
                        if (IN16) { const u32x4 h = xh[mm][bj]; x0 = (f32x4){bflo(h.x), bfhi(h.x), bflo(h.y), bfhi(h.y)}; x1 = (f32x4){bflo(h.z), bfhi(h.z), bflo(h.w), bfhi(h.w)}; }
                        else { x0 = xr[mm][bj][0]; x1 = xr[mm][bj][1]; }
                        const f32x4 v0 = x0 + gv[bj][0] * acc[ai][bj][m][0], v1 = x1 + gv[bj][1] * acc[ai][bj][m][1];
                        if (OUT16) { u32x4 w; w.x = cvtpk(v0[0], v0[1]); w.y = cvtpk(v0[2], v0[3]); w.z = cvtpk(v1[0], v1[1]); w.w = cvtpk(v1[2], v1[3]); *(u32x4*)((bf16_t*)xout + off) = w; }
                        else { *(f32x4*)((float*)xout + off) = v0; *(f32x4*)((float*)xout + off + 4) = v1; }
                        s += (v0[0] * v0[0] + v0[1] * v0[1]) + (v0[2] * v0[2] + v0[3] * v0[3]) + (v1[0] * v1[0] + v1[1] * v1[1]) + (v1[2] * v1[2] + v1[3] * v1[3]);
                        if (xb1) { const float* wp = wk1 + b * D + col0 + bj * HALF; const f32x4 w0 = *(const f32x4*)wp, w1 = *(const f32x4*)(wp + 4);
                            u32x4 w; w.x = cvtpk(v0[0] * w0[0], v0[1] * w0[1]); w.y = cvtpk(v0[2] * w0[2], v0[3] * w0[3]); w.z = cvtpk(v1[0] * w1[0], v1[1] * w1[1]); w.w = cvtpk(v1[2] * w1[2], v1[3] * w1[3]);
                            *(u32x4*)(xb1 + off) = w; }
                        if (xb2) { const float* wp = wk2 + b * D + col0 + bj * HALF; const f32x4 w0 = *(const f32x4*)wp, w1 = *(const f32x4*)(wp + 4);
                            u32x4 w; w.x = cvtpk(v0[0] * w0[0], v0[1] * w0[1]); w.y = cvtpk(v0[2] * w0[2], v0[3] * w0[3]); w.z = cvtpk(v1[0] * w1[0], v1[1] * w1[1]); w.w = cvtpk(v1[2] * w1[2], v1[3] * w1[3]);
                            *(u32x4*)(xb2 + off) = w; }
                    }
                    if (ssq) { s += __shfl_xor(s, 16); s += __shfl_xor(s, 32); if (fq == 0) red[rl * 4 + wc] = s; }
                }
                asm volatile("" ::: "memory");
            }
        if (ssq) {
            asm volatile("s_waitcnt lgkmcnt(0)" ::: "memory"); __builtin_amdgcn_s_barrier(); asm volatile("" ::: "memory");
            const int tid = (wr * 4 + wc) * 64 + fq * 16 + fr;
            if (tid < 256) { const f32x4 p = *(const LAS f32x4*)(red + tid * 4); ssq[(size_t)(u.pm * BM + tid) * 4 + u.pn] = (p[0] + p[1]) + (p[2] + p[3]); }
            asm volatile("s_waitcnt lgkmcnt(0)" ::: "memory"); __builtin_amdgcn_s_barrier(); asm volatile("" ::: "memory");
        }
    }
};
struct EpiProj {
    const float* bias; int N; const float* ssq; bf16_t* dstH; bf16_t* dstVT;
    __device__ __forceinline__ void operator()(const f32x4 (&acc)[2][2][4][2], const Unit& u, int wr, int wc, int fr_, int fq_) const {
        int fr = fr_, fq = fq_; asm volatile("" : "+v"(fr), "+v"(fq));
        const int b = u.pm >= (T / BM) ? 1 : 0, blk = u.pm & (NBLK - 1);
        float rs[2][4];
#pragma unroll
        for (int ai = 0; ai < 2; ++ai)
#pragma unroll
            for (int m = 0; m < 4; ++m) rs[ai][m] = rstd_of(ssq + (size_t)(u.pm * BM + ai * HALF + wr * 64 + m * 16 + fr) * 4);
        const float* bp = bias + b * N + u.pn * 256 + wc * 32 + 8 * fq;
        if (u.pn < 4) {
#pragma unroll
            for (int bj = 0; bj < 2; ++bj) {
                f32x4 bv[2][2]; bv[bj][0] = *(const f32x4*)(bp + bj * HALF); bv[bj][1] = *(const f32x4*)(bp + bj * HALF + 4);
                const int h = 2 * u.pn + bj;
                bf16_t* hb = dstH + ((size_t)(b * NH + h) * T + blk * BS) * HD + wc * 32 + 8 * fq;
#pragma unroll
                for (int ai = 0; ai < 2; ++ai)
#pragma unroll
                    for (int m = 0; m < 4; ++m) {
                        const f32x4 v0 = acc[ai][bj][m][0] * rs[ai][m] + bv[bj][0], v1 = acc[ai][bj][m][1] * rs[ai][m] + bv[bj][1];
                        u32x4 w; w.x = cvtpk(v0[0], v0[1]); w.y = cvtpk(v0[2], v0[3]); w.z = cvtpk(v1[0], v1[1]); w.w = cvtpk(v1[2], v1[3]);
                        *(u32x4*)(hb + (unsigned)((ai * HALF + wr * 64 + m * 16 + fr) * HD)) = w;
                        asm volatile("" ::: "memory");
                    }
            }
        } else {
            const int pc = 16 * wr + fr;
#pragma unroll
            for (int bj = 0; bj < 2; ++bj) {
                f32x4 bv[2][2]; bv[bj][0] = *(const f32x4*)(bp + bj * HALF); bv[bj][1] = *(const f32x4*)(bp + bj * HALF + 4);
                const int h = 2 * (u.pn - 4) + bj;
                bf16_t* vb = dstVT + ((size_t)(b * NH + h) * NBLK + blk) * (HD * BS);
#pragma unroll
                for (int n = 0; n < 2; ++n)
#pragma unroll
                    for (int i = 0; i < 4; ++i) {
                        const int d = wc * 32 + 8 * fq + 4 * n + i;
                        const float bb = bv[bj][n][i];
                        u32x4 w;
                        w.x = cvtpk(acc[0][bj][0][n][i] * rs[0][0] + bb, acc[0][bj][1][n][i] * rs[0][1] + bb);
                        w.y = cvtpk(acc[0][bj][2][n][i] * rs[0][2] + bb, acc[0][bj][3][n][i] * rs[0][3] + bb);
                        w.z = cvtpk(acc[1][bj][0][n][i] * rs[1][0] + bb, acc[1][bj][1][n][i] * rs[1][1] + bb);
                        w.w = cvtpk(acc[1][bj][2][n][i] * rs[1][2] + bb, acc[1][bj][3][n][i] * rs[1][3] + bb);
                        *(u32x4*)(vb + (unsigned)(d * BS + ((pc ^ (d & 15)) << 3))) = w;
                        asm volatile("" ::: "memory");
                    }
            }
        }
    }
};
}

struct Args { const float* in[17]; float* out; unsigned char* ws; int ph_lo, ph_hi; };

struct Frame {
    LAS unsigned char* lds;
    int wave, G, bid;
    unsigned char* ws;
};
#define FTID const int f_lane = lane_id(); const int f_tid = F.wave * 64 + f_lane; (void)f_tid

__device__ __forceinline__ void transpose_item(const float* W, int K, int N, bf16_t* WT, bool winperm, LAS float* scr, int item, int lane) {
    const int nblk = N / 32, kb = item / nblk, nb = item % nblk, k0 = 64 * kb, n0 = 32 * nb;
    float tv[32];
#pragma unroll
    for (int i = 0; i < 32; ++i) tv[i] = __builtin_nontemporal_load(W + (size_t)(k0 + 2 * i + (lane >> 5)) * N + n0 + (lane & 31));
#pragma unroll
    for (int i = 0; i < 32; ++i) scr[(2 * i + (lane >> 5)) * 33 + (lane & 31)] = tv[i];
    asm volatile("s_waitcnt lgkmcnt(0)" ::: "memory");
    int r0 = n0;
    if (winperm) { const int bj = n0 / FF, j = n0 % FF; r0 = 256 * (j / 128) + 128 * bj + (j % 128); }
    const int c = lane & 7;
#pragma unroll
    for (int j = 0; j < 4; ++j) { const int n = (lane >> 3) + 8 * j; const LAS float* s = scr + (8 * c) * 33 + n;
        u32x4 o; o.x = cvtpk(s[0 * 33], s[1 * 33]); o.y = cvtpk(s[2 * 33], s[3 * 33]); o.z = cvtpk(s[4 * 33], s[5 * 33]); o.w = cvtpk(s[6 * 33], s[7 * 33]);
        *(u32x4*)(WT + (size_t)(r0 + n) * K + k0 + 8 * c) = o; }
    asm volatile("s_waitcnt lgkmcnt(0)" ::: "memory");
}

__device__ __forceinline__ void phase0(Frame& F, const Args& a) {
    FTID;
    const int gw = F.bid * NWAVES + F.wave, NGW = F.G * NWAVES;
    {
        LAS float* scr = (LAS float*)(F.lds + F.wave * 8448);
        constexpr int I_IN = (D / 64) * (NIN / 32), I_OUT = (FF / 64) * (D / 32), I_KV = (D / 64) * (2 * D / 32), I_Q = (D / 64) * (D / 32), I_P = (256 / 64) * (256 / 32);
        constexpr int NITEMS = 4 * I_IN + 4 * I_OUT + I_KV + 2 * I_Q + 4 * I_P;
        const float* w_in = a.in[5]; const float* w_out = a.in[6]; const float* pool_w = a.in[7]; const float* w_kv = a.in[12]; const float* w_q = a.in[14]; const float* w_o = a.in[16];
        bf16_t* WIN = (bf16_t*)(F.ws + WS_WIN); bf16_t* WOUT = (bf16_t*)(F.ws + WS_WOUT); bf16_t* WKV = (bf16_t*)(F.ws + WS_WKV); bf16_t* WQ = (bf16_t*)(F.ws + WS_WQ); bf16_t* WO = (bf16_t*)(F.ws + WS_WO); bf16_t* WP = (bf16_t*)(F.ws + WS_WPOOL);
        for (int it = gw; it < NITEMS; it += NGW) {
            int r = it;
            if (r < 4 * I_IN) { const int f = r / I_IN; transpose_item(w_in + (size_t)f * D * NIN, D, NIN, WIN + (size_t)f * NIN * D, true, scr, r % I_IN, f_lane); continue; } r -= 4 * I_IN;
            if (r < 4 * I_OUT) { const int f = r / I_OUT; transpose_item(w_out + (size_t)f * FF * D, FF, D, WOUT + (size_t)f * D * FF, false, scr, r % I_OUT, f_lane); continue; } r -= 4 * I_OUT;
            if (r < I_KV) { transpose_item(w_kv, D, 2 * D, WKV, false, scr, r, f_lane); continue; } r -= I_KV;
            if (r < I_Q) { transpose_item(w_q, D, D, WQ, false, scr, r, f_lane); continue; } r -= I_Q;
            if (r < I_Q) { transpose_item(w_o, D, D, WO, false, scr, r, f_lane); continue; } r -= I_Q;
            { const int gi = r / I_P; transpose_item(pool_w + (size_t)gi * 65536, 256, 256, WP + (size_t)gi * 65536, false, scr, r % I_P, f_lane); }
        }
    }
    __syncthreads();
    {
        LAS float* cs = (LAS float*)(F.lds + 81920);
        const float* c = a.in[1];
        for (int i = f_tid; i < 2 * D; i += 512) { const float v = c[i]; cs[i] = v / (1.0f + __expf(-v)); }
        __syncthreads();
        const float* ada_w = a.in[2]; const float* kv_ada_w = a.in[10];
        float* MODP = (float*)(F.ws + WS_MODP);
        constexpr int NCC = NMODCOL / 512;
        for (int un = F.bid; un < NCC * KSPLIT; un += F.G) {
            const int cc = un % NCC, ks = un / NCC, n = cc * 512 + f_tid;
            const float* wp; int ldw;
            if (n < 9 * D) { wp = ada_w + n; ldw = 9 * D; } else if (n < 18 * D) { wp = ada_w + (size_t)D * 9 * D + (n - 9 * D); ldw = 9 * D; } else { wp = kv_ada_w + (n - 18 * D); ldw = 2 * D; }
            float a0 = 0.f, a1 = 0.f;
            const int k0 = ks * (D / KSPLIT);
#pragma unroll 32
            for (int k = 0; k < D / KSPLIT; ++k) { const float w = __builtin_nontemporal_load(wp + (size_t)(k0 + k) * ldw); a0 += cs[k0 + k] * w; a1 += cs[D + k0 + k] * w; }
            MODP[(size_t)(ks * 2 + 0) * NMODCOL + n] = a0; MODP[(size_t)(ks * 2 + 1) * NMODCOL + n] = a1;
        }
    }
    {
        f32x2_t* ROPE = (f32x2_t*)(F.ws + WS_ROPE);
        for (int idx = F.bid * 512 + f_tid; idx < T * 64; idx += F.G * 512) {
            const int pos = idx >> 6, i = idx & 63;
            double inv = 1.0, rr = 0.8659643233600653;
#pragma unroll
            for (int k = 0; k < 6; ++k) { if ((i >> k) & 1) inv *= rr; rr *= rr; }
            const double th2 = inv * inv; double cc = 1.0, ss = 1.0;
#pragma unroll
            for (int k = 11; k >= 1; --k) { cc = 1.0 - th2 * (1.0 / (double)((2 * k - 1) * (2 * k))) * cc; ss = 1.0 - th2 * (1.0 / (double)((2 * k) * (2 * k + 1))) * ss; }
            double ck = cc, sk = inv * ss, C = 1.0, S = 0.0;
#pragma unroll
            for (int k = 0; k < 14; ++k) { if ((pos >> k) & 1) { const double nc = C * ck - S * sk, ns = S * ck + C * sk; C = nc; S = ns; } const double c2 = ck * ck - sk * sk, s2 = 2.0 * sk * ck; ck = c2; sk = s2; }
            ROPE[idx] = (f32x2_t){(float)C, (float)S};
        }
    }
}

__device__ __forceinline__ void phase1(Frame& F, const Args& a) {
    FTID;
    const float* MODP = (const float*)(F.ws + WS_MODP); float* VEC = (float*)(F.ws + WS_VEC);
    const float* ada_b = a.in[3]; const float* norm_g = a.in[4]; const float* pool_scale = a.in[8]; const float* kv_norm = a.in[9]; const float* kv_ada_b = a.in[11];
    for (int gi = F.bid * 512 + f_tid; gi < 2 * NMODCOL; gi += F.G * 512) {
        const int b = gi / NMODCOL, n = gi % NMODCOL;
        float v = 0.f;
#pragma unroll
        for (int ks = 0; ks < KSPLIT; ++ks) v += MODP[(size_t)(ks * 2 + b) * NMODCOL + n];
        if (n < 18 * D) {
            const int l = n / (9 * D), nn = n % (9 * D), ch = nn / D, k = nn % D, s = ch / 3, role = ch % 3, sub = 3 * l + s;
            v += ada_b[l * 9 * D + nn];
            if (role == 0) VEC[((1 * 7 + sub) * 2 + b) * D + k] = v;
            else if (role == 1) VEC[((0 * 7 + sub) * 2 + b) * D + k] = norm_g[(l * 3 + s) * D + k] * (1.0f + v);
            else VEC[((2 * 7 + sub) * 2 + b) * D + k] = (s == 1 ? 1.0f : 0.5f) * (1.0f + v) * (sub == 1 ? pool_scale[k] : 1.0f);
        } else {
            const int nn = n - 18 * D; v += kv_ada_b[nn];
            if (nn < D) VEC[((1 * 7 + 6) * 2 + b) * D + nn] = v; else VEC[((0 * 7 + 6) * 2 + b) * D + (nn - D)] = kv_norm[nn - D] * (1.0f + v);
        }
    }
    if (F.bid == 0 && f_tid == 0) {
        const float* kn = a.in[13]; const float* qn = a.in[15]; float mq = 0.f, mk = 0.f;
        for (int i = 0; i < HD; ++i) { mq = fmaxf(mq, fabsf(qn[i])); mk = fmaxf(mk, fabsf(kn[i])); }
        *(float*)(F.ws + WS_CREF) = 11.313708498984761f * mq * mk * 1.4426950408889634f;
    }
}

__device__ __forceinline__ void phase2(Frame& F, const Args& a) {
    FTID;
    const int gw = F.bid * NWAVES + F.wave, NGW = F.G * NWAVES;
    const float* VEC = (const float*)(F.ws + WS_VEC); float* BIAS = (float*)(F.ws + WS_BIAS);
    constexpr int NROWS = 4 * NIN + 2 * D + D;
    for (int r = 4 * gw; r < NROWS; r += 4 * NGW) {
        const bf16_t* wrow; int sub; float* o0; float* o1;
        if (r < 4 * NIN) { const int f = r / NIN, n = r % NIN; wrow = (const bf16_t*)(F.ws + WS_WIN) + ((size_t)f * NIN + n) * D; sub = (f == 0) ? 0 : (f == 1) ? 2 : (f == 2) ? 3 : 5; o0 = BIAS + (f * 2 + 0) * NIN + n; o1 = BIAS + (f * 2 + 1) * NIN + n; }
        else if (r < 4 * NIN + 2 * D) { const int n = r - 4 * NIN; wrow = (const bf16_t*)(F.ws + WS_WKV) + (size_t)n * D; sub = 6; o0 = BIAS + 8 * NIN + n; o1 = BIAS + 8 * NIN + 2 * D + n; }
        else { const int n = r - 4 * NIN - 2 * D; wrow = (const bf16_t*)(F.ws + WS_WQ) + (size_t)n * D; sub = 4; o0 = BIAS + 8 * NIN + 4 * D + n; o1 = BIAS + 8 * NIN + 4 * D + D + n; }
        u32x4 w0[4], w1[4];
#pragma unroll
        for (int q = 0; q < 4; ++q) { w0[q] = *(const u32x4*)(wrow + (size_t)q * D + f_lane * 16); w1[q] = *(const u32x4*)(wrow + (size_t)q * D + f_lane * 16 + 8); }
        const float* s0 = VEC + ((1 * 7 + sub) * 2 + 0) * D + f_lane * 16; const float* s1 = s0 + D;
        f32x4 p[4], q4[4];
#pragma unroll
        for (int j = 0; j < 4; ++j) { p[j] = *(const f32x4*)(s0 + 4 * j); q4[j] = *(const f32x4*)(s1 + 4 * j); }
        float a0[4], a1[4];
#pragma unroll
        for (int q = 0; q < 4; ++q) {
            float wv[16];
            wv[0] = bflo(w0[q].x); wv[1] = bfhi(w0[q].x); wv[2] = bflo(w0[q].y); wv[3] = bfhi(w0[q].y); wv[4] = bflo(w0[q].z); wv[5] = bfhi(w0[q].z); wv[6] = bflo(w0[q].w); wv[7] = bfhi(w0[q].w);
            wv[8] = bflo(w1[q].x); wv[9] = bfhi(w1[q].x); wv[10] = bflo(w1[q].y); wv[11] = bfhi(w1[q].y); wv[12] = bflo(w1[q].z); wv[13] = bfhi(w1[q].z); wv[14] = bflo(w1[q].w); wv[15] = bfhi(w1[q].w);
            float x0 = 0.f, x1 = 0.f;
#pragma unroll
            for (int j = 0; j < 4; ++j)
#pragma unroll
                for (int e = 0; e < 4; ++e) { x0 += p[j][e] * wv[4 * j + e]; x1 += q4[j][e] * wv[4 * j + e]; }
            a0[q] = x0; a1[q] = x1;
        }
#pragma unroll
        for (int o = 1; o < 64; o <<= 1) {
#pragma unroll
            for (int q = 0; q < 4; ++q) { a0[q] += __shfl_xor(a0[q], o); a1[q] += __shfl_xor(a1[q], o); } }
        if (f_lane == 0) {
#pragma unroll
            for (int q = 0; q < 4; ++q) { o0[q] = a0[q]; o1[q] = a1[q]; } }
    }
    const float* x = a.in[0]; bf16_t* XB = (bf16_t*)(F.ws + WS_XB); float* SSQ = (float*)(F.ws + WS_SSQA);
#pragma unroll 2
    for (int m = gw; m < M; m += NGW) {
        const int b = m >= T ? 1 : 0;
        const f32x4* xr = (const f32x4*)(x + (size_t)m * D) + f_lane; const f32x4* wk = (const f32x4*)(VEC + ((0 * 7 + 0) * 2 + b) * D) + f_lane;
        f32x4 v[4]; float s = 0.f;
#pragma unroll
        for (int j = 0; j < 4; ++j) { v[j] = __builtin_nontemporal_load(xr + 64 * j); s += (v[j][0] * v[j][0] + v[j][1] * v[j][1]) + (v[j][2] * v[j][2] + v[j][3] * v[j][3]); }
        s = wave_sum(s);
        u32x2* o8 = (u32x2*)(XB + (size_t)m * D) + f_lane;
#pragma unroll
        for (int j = 0; j < 4; ++j) { const f32x4 w = wk[64 * j]; u32x2 o; o.x = cvtpk(v[j][0] * w[0], v[j][1] * w[1]); o.y = cvtpk(v[j][2] * w[2], v[j][3] * w[3]); o8[64 * j] = o; }
        if (f_lane < 4) SSQ[(size_t)m * 4 + f_lane] = (f_lane == 0) ? s : 0.f;
    }
}

__device__ __forceinline__ void phase_pool_elem(Frame& F, const bf16_t* x, const float* ssq) {
    FTID;
    const float* VEC = (const float*)(F.ws + WS_VEC); bf16_t* OUT = (bf16_t*)(F.ws + WS_XB2);
    LAS float* rsl = (LAS float*)F.lds;
    const int gi = F.wave >> 1, w = 2 << gi;
    const int tq = (f_tid >> 5) & 3, c = 8 * ((f_tid & 31) | (gi << 5));
    for (int un = F.bid; un < M / 64; un += F.G) {
        const int m0 = un * 64, b = m0 >= T ? 1 : 0, bstart = b * T;
        __syncthreads();
        if (f_tid < 79) { const int tok = m0 - 15 + f_tid; rsl[f_tid] = (tok >= bstart) ? rstd_of(ssq + (size_t)tok * 4) : 0.f; }
        __syncthreads();
        const f32x4 wk0 = *(const f32x4*)(VEC + ((0 * 7 + 1) * 2 + b) * D + c), wk1 = *(const f32x4*)(VEC + ((0 * 7 + 1) * 2 + b) * D + c + 4);
        const int t0 = m0 + 16 * tq;
        f32x4 sa = {0.f, 0.f, 0.f, 0.f}, sb = {0.f, 0.f, 0.f, 0.f};
#define POOL_UNPK(h_, r_, a_, b_) do { a_ = (f32x4){bflo(h_.x), bfhi(h_.x), bflo(h_.y), bfhi(h_.y)} * (r_); b_ = (f32x4){bflo(h_.z), bfhi(h_.z), bflo(h_.w), bfhi(h_.w)} * (r_); } while (0)
#pragma nounroll
        for (int sx = t0 - w + 1; sx < t0; ++sx) if (sx >= bstart) { const u32x4 h = *(const u32x4*)(x + (size_t)sx * D + c); f32x4 a, bb; POOL_UNPK(h, rsl[sx - m0 + 15], a, bb); sa += a; sb += bb; }
#pragma unroll 8
        for (int t = t0; t < t0 + 16; ++t) {
            const u32x4 h = *(const u32x4*)(x + (size_t)t * D + c); f32x4 xa, xb_; POOL_UNPK(h, rsl[t - m0 + 15], xa, xb_);
            sa += xa; sb += xb_;
            const int tb = t - bstart; const float ic = 1.0f / (float)(tb + 1 < w ? tb + 1 : w);
            const f32x4 oa = wk0 * (sa * ic - xa), ob = wk1 * (sb * ic - xb_);
            u32x4 o; o.x = cvtpk(oa[0], oa[1]); o.y = cvtpk(oa[2], oa[3]); o.z = cvtpk(ob[0], ob[1]); o.w = cvtpk(ob[2], ob[3]);
            *(u32x4*)(OUT + (size_t)t * D + c) = o;
            const int so = t - w + 1;
            if (so >= bstart) { const u32x4 ho = *(const u32x4*)(x + (size_t)so * D + c); f32x4 a, bb; POOL_UNPK(ho, rsl[so - m0 + 15], a, bb); sa -= a; sb -= bb; }
        }
#undef POOL_UNPK
    }
}

__device__ __forceinline__ int key_of_pos(int p) { return 128 * ((p & 7) >> 2) + 64 * (p >> 7) + 16 * (p & 3) + ((p >> 3) & 15); }
__device__ __forceinline__ int pos_of_krow(int R) { return (R & ~12) | ((R & 4) << 1) | ((R & 8) >> 1); }

__device__ __forceinline__ void phase_kvprep(Frame& F, const Args& a) {
    FTID;
    bf16_t* KN = (bf16_t*)(F.ws + WS_KN); float* KMEAN = (float*)(F.ws + WS_KMEAN); const f32x2_t* ROPE = (const f32x2_t*)(F.ws + WS_ROPE);
    const float* k_norm = a.in[13];
    LAS float* part = (LAS float*)F.lds;
    const int lane = f_lane, ch = lane & 15, rsub = lane >> 4;
    const f32x4 gk0 = *(const f32x4*)(k_norm + 8 * ch), gk1 = *(const f32x4*)(k_norm + 8 * ch + 4);
    const float sgn = (ch < 8) ? -1.0f : 1.0f;
    for (int it = F.bid; it < BATCH * NH * NBLK; it += F.G) {
        const int blk = it & (NBLK - 1);
        bf16_t* base = KN + (size_t)it * (BS * HD);
        u32x4 raw[8];
#pragma unroll
        for (int p = 0; p < 8; ++p) raw[p] = *(const u32x4*)(base + (size_t)(p * 32 + F.wave * 4 + rsub) * HD + 8 * ch);
        asm volatile("s_waitcnt vmcnt(0)" ::: "memory");
        __syncthreads();
        float cs8[8] = {0.f, 0.f, 0.f, 0.f, 0.f, 0.f, 0.f, 0.f};
#pragma unroll
        for (int p = 0; p < 8; ++p) {
            const int row = p * 32 + F.wave * 4 + rsub, pos = blk * BS + row;
            const f32x4* rt = (const f32x4*)(ROPE + (size_t)pos * 64 + 8 * (ch & 7));
            const f32x4 c0 = rt[0], c1 = rt[1], c2 = rt[2], c3 = rt[3];
            const u32x4 rw = raw[p];
            float x[8] = {bflo(rw.x), bfhi(rw.x), bflo(rw.y), bfhi(rw.y), bflo(rw.z), bfhi(rw.z), bflo(rw.w), bfhi(rw.w)};
            float ss = 0.f;
#pragma unroll
            for (int e = 0; e < 8; ++e) ss += x[e] * x[e];
            ss += __shfl_xor(ss, 1); ss += __shfl_xor(ss, 2); ss += __shfl_xor(ss, 4); ss += __shfl_xor(ss, 8);
            const float rs = __builtin_amdgcn_rsqf(ss * (1.0f / HD) + EPS);
            float y[8], py[8];
#pragma unroll
            for (int e = 0; e < 4; ++e) { y[e] = x[e] * rs * gk0[e]; y[4 + e] = x[4 + e] * rs * gk1[e]; }
#pragma unroll
            for (int e = 0; e < 8; ++e) py[e] = __shfl_xor(y[e], 8);
            const float cs_[8] = {c0[0], c0[2], c1[0], c1[2], c2[0], c2[2], c3[0], c3[2]}, sn_[8] = {c0[1], c0[3], c1[1], c1[3], c2[1], c2[3], c3[1], c3[3]};
            float o[8];
#pragma unroll
            for (int e = 0; e < 8; ++e) { o[e] = y[e] * cs_[e] + sgn * py[e] * sn_[e]; cs8[e] += o[e]; }
            u32x4 w; w.x = cvtpk(o[0], o[1]); w.y = cvtpk(o[2], o[3]); w.z = cvtpk(o[4], o[5]); w.w = cvtpk(o[6], o[7]);
            const int pp = 8 * (16 * ((row >> 6) & 1) + (row & 15)) + 4 * (row >> 7) + ((row >> 4) & 3);
            const int R = (pp & ~12) | ((pp & 4) << 1) | ((pp & 8) >> 1);
            *(u32x4*)(base + (size_t)R * HD + ((ch ^ (R & 15)) << 3)) = w;
        }
#pragma unroll
        for (int e = 0; e < 8; ++e) { cs8[e] += __shfl_xor(cs8[e], 16); cs8[e] += __shfl_xor(cs8[e], 32); }
        if (rsub == 0) { *(LAS f32x4*)(part + F.wave * 128 + 8 * ch) = (f32x4){cs8[0], cs8[1], cs8[2], cs8[3]}; *(LAS f32x4*)(part + F.wave * 128 + 8 * ch + 4) = (f32x4){cs8[4], cs8[5], cs8[6], cs8[7]}; }
        __syncthreads();
        if (f_tid < 128) { float sm = 0.f;
#pragma unroll
            for (int wv = 0; wv < 8; ++wv) sm += part[wv * 128 + f_tid];
            KMEAN[(size_t)it * HD + f_tid] = sm * (1.0f / BS); }
    }
    __syncthreads();
}

__device__ __forceinline__ void phase_sel(Frame& F, const Args& a) {
    FTID;
    bf16_t* QN = (bf16_t*)(F.ws + WS_QN); const float* KMEAN = (const float*)(F.ws + WS_KMEAN); const f32x2_t* ROPE = (const f32x2_t*)(F.ws + WS_ROPE);
    unsigned* CNT = (unsigned*)(F.ws + WS_CNT); unsigned short* LIST = (unsigned short*)(F.ws + WS_LIST);
    const float* q_norm = a.in[15];
    LAS unsigned char* QT = F.lds;
    LAS unsigned char* KMH = F.lds + 65536;
    LAS unsigned char* KML = F.lds + 81920;
    LAS unsigned* hist = (LAS unsigned*)(F.lds + 98304);
    const int lane = f_lane, ch = lane & 15, rsub = lane >> 4;
    const f32x4 gq0 = *(const f32x4*)(q_norm + 8 * ch), gq1 = *(const f32x4*)(q_norm + 8 * ch + 4);
    const float sgn = (ch < 8) ? -1.0f : 1.0f;
    for (int it = F.bid; it < BATCH * NH * NBLK; it += F.G) {
        const int bh = it >> 6; int n = it & 63; { const int rr = (bh >> 2) & 3; if (rr & 2) n ^= 32; if (rr & 1) n = 63 - n; }
        __syncthreads();
        if (f_tid < 64) hist[f_tid] = 0u;
#pragma unroll
        for (int k2 = 0; k2 < 2; ++k2) {
            const int cidx = f_tid + 512 * k2, j = cidx >> 4, c = cidx & 15;
            u32x4 hw = {0u, 0u, 0u, 0u}, lw = {0u, 0u, 0u, 0u};
            if (j < n) { const float* kp = KMEAN + ((size_t)bh * NBLK + j) * HD + 8 * c; const f32x4 v0 = *(const f32x4*)kp, v1 = *(const f32x4*)(kp + 4);
                hw.x = cvtpk(v0[0], v0[1]); hw.y = cvtpk(v0[2], v0[3]); hw.z = cvtpk(v1[0], v1[1]); hw.w = cvtpk(v1[2], v1[3]);
                lw.x = cvtpk(v0[0] - bflo(hw.x), v0[1] - bfhi(hw.x)); lw.y = cvtpk(v0[2] - bflo(hw.y), v0[3] - bfhi(hw.y));
                lw.z = cvtpk(v1[0] - bflo(hw.z), v1[1] - bfhi(hw.z)); lw.w = cvtpk(v1[2] - bflo(hw.w), v1[3] - bfhi(hw.w)); }
            *(LAS u32x4*)(KMH + j * 256 + ((c ^ (j & 15)) << 4)) = hw; *(LAS u32x4*)(KML + j * 256 + ((c ^ (j & 15)) << 4)) = lw;
        }
#pragma unroll 2
        for (int p = 0; p < 8; ++p) {
            const int row = p * 32 + F.wave * 4 + rsub, t = n * BS + row;
            bf16_t* rp = QN + ((size_t)bh * T + t) * HD + 8 * ch;
            const u32x4 raw = *(const u32x4*)rp;
            const f32x4* rt = (const f32x4*)(ROPE + (size_t)t * 64 + 8 * (ch & 7));
            const f32x4 c0 = rt[0], c1 = rt[1], c2 = rt[2], c3 = rt[3];
            float x[8] = {bflo(raw.x), bfhi(raw.x), bflo(raw.y), bfhi(raw.y), bflo(raw.z), bfhi(raw.z), bflo(raw.w), bfhi(raw.w)};
            float ss = 0.f;
#pragma unroll
            for (int e = 0; e < 8; ++e) ss += x[e] * x[e];
            ss += __shfl_xor(ss, 1); ss += __shfl_xor(ss, 2); ss += __shfl_xor(ss, 4); ss += __shfl_xor(ss, 8);
            const float rs = __builtin_amdgcn_rsqf(ss * (1.0f / HD) + EPS);
            float y[8], py[8];
#pragma unroll
            for (int e = 0; e < 4; ++e) { y[e] = x[e] * rs * gq0[e]; y[4 + e] = x[4 + e] * rs * gq1[e]; }
#pragma unroll
            for (int e = 0; e < 8; ++e) py[e] = __shfl_xor(y[e], 8);
            const float cs_[8] = {c0[0], c0[2], c1[0], c1[2], c2[0], c2[2], c3[0], c3[2]}, sn_[8] = {c0[1], c0[3], c1[1], c1[3], c2[1], c2[3], c3[1], c3[3]};
            float o[8];
#pragma unroll
            for (int e = 0; e < 8; ++e) o[e] = y[e] * cs_[e] + sgn * py[e] * sn_[e];
            u32x4 w; w.x = cvtpk(o[0], o[1]); w.y = cvtpk(o[2], o[3]); w.z = cvtpk(o[4], o[5]); w.w = cvtpk(o[6], o[7]);
            *(u32x4*)rp = w;
            *(LAS u32x4*)(QT + row * 256 + ((ch ^ (row & 15)) << 4)) = w;
        }
        __syncthreads();
        const int q = lane & 31, hi = lane >> 5, sw = q & 15, qrow = 32 * F.wave + q;
        bf16x8 qf[8];
#pragma unroll
        for (int d0 = 0; d0 < 8; ++d0) qf[d0] = *(const LAS bf16x8*)(QT + qrow * 256 + (((2 * d0 + hi) ^ sw) << 4));
        float g0 = -INFINITY, g1 = -INFINITY, g2 = -INFINITY; int j0 = 0, j1 = 1, j2 = 2;
#define SEL_INS(gt_, jt_) do { const float gt = (gt_); const int jt = (jt_); \
            if (gt > g0 || (gt == g0 && jt < j0)) { g2 = g1; j2 = j1; g1 = g0; j1 = j0; g0 = gt; j0 = jt; } \
            else if (gt > g1 || (gt == g1 && jt < j1)) { g2 = g1; j2 = j1; g1 = gt; j1 = jt; } \
            else if (gt > g2 || (gt == g2 && jt < j2)) { g2 = gt; j2 = jt; } } while (0)
#pragma unroll
        for (int tau = 0; tau < 2; ++tau) {
            if (32 * tau < n) {
                f32x16 sacc = {};
                const LAS unsigned char* kh = KMH + (32 * tau + q) * 256; const LAS unsigned char* kl = KML + (32 * tau + q) * 256;
#pragma unroll
                for (int d0 = 0; d0 < 8; ++d0) {
                    const bf16x8 ah = *(const LAS bf16x8*)(kh + (((2 * d0 + hi) ^ sw) << 4)), al = *(const LAS bf16x8*)(kl + (((2 * d0 + hi) ^ sw) << 4));
                    sacc = __builtin_amdgcn_mfma_f32_32x32x16_bf16(ah, qf[d0], sacc, 0, 0, 0);
                    sacc = __builtin_amdgcn_mfma_f32_32x32x16_bf16(al, qf[d0], sacc, 0, 0, 0);
                }
#pragma unroll
                for (int r = 0; r < 16; ++r) { const int jb = 32 * tau + (r & 3) + 8 * (r >> 2) + 4 * hi; if (jb < n) SEL_INS(sacc[r], jb); }
            }
        }
        {
            const float pg0 = __shfl_xor(g0, 32), pg1 = __shfl_xor(g1, 32), pg2 = __shfl_xor(g2, 32);
            const int pj0 = __shfl_xor(j0, 32), pj1 = __shfl_xor(j1, 32), pj2 = __shfl_xor(j2, 32);
            if (pg0 > -INFINITY) SEL_INS(pg0, pj0);
            if (pg1 > -INFINITY) SEL_INS(pg1, pj1);
            if (pg2 > -INFINITY) SEL_INS(pg2, pj2);
        }
#undef SEL_INS
        const int t = n * BS + qrow;
        const int nsel = (hi == 0) ? (n < 3 ? n : 3) : 0;
        if (n < 3) { j0 = 0; j1 = 1; j2 = 2; }
        unsigned l0 = 0, l1 = 0, l2 = 0;
        if (nsel > 0) l0 = atomicAdd((unsigned*)&hist[j0], 1u);
        if (nsel > 1) l1 = atomicAdd((unsigned*)&hist[j1], 1u);
        if (nsel > 2) l2 = atomicAdd((unsigned*)&hist[j2], 1u);
        __syncthreads();
        if (f_tid < 64) { const unsigned c = hist[f_tid]; hist[64 + f_tid] = c ? atomicAdd(&CNT[bh * NBLK + f_tid], c) : 0u; }
        __syncthreads();
        unsigned short* lb = LIST + (size_t)bh * NBLK * T;
        if (nsel > 0) lb[(size_t)j0 * T + hist[64 + j0] + l0] = (unsigned short)((t << 2) | 0);
        if (nsel > 1) lb[(size_t)j1 * T + hist[64 + j1] + l1] = (unsigned short)((t << 2) | 1);
        if (nsel > 2) lb[(size_t)j2 * T + hist[64 + j2] + l2] = (unsigned short)((t << 2) | 2);
    }
    __syncthreads();
}

template <bool CAUSAL>
__device__ __forceinline__ void attn_qk(const LAS unsigned char* kl, const bf16x8 (&qf)[8], u32x4 (&pk)[8][2], float& lsum, int qrow, int lane, float c1, float c2) {
    const int i = lane & 31, hi = lane >> 5, sw = i & 15;
    int qr = qrow - hi; asm volatile("" : "+v"(qr));
#pragma unroll
    for (int tau = 0; tau < 8; ++tau) {
        f32x16 s = {};
        const LAS unsigned char* kp = kl + (32 * tau + i) * 256;
#pragma unroll
        for (int d0 = 0; d0 < 8; ++d0) { const bf16x8 kf = *(const LAS bf16x8*)(kp + (((2 * d0 + hi) ^ sw) << 4)); s = __builtin_amdgcn_mfma_f32_32x32x16_bf16(kf, qf[d0], s, 0, 0, 0); }
        float p[16];
#pragma unroll
        for (int r = 0; r < 16; ++r) {
            float e = __builtin_amdgcn_exp2f(s[r] * c1 - c2);
            if (CAUSAL) { const int keyc = 128 * ((r >> 2) & 1) + 64 * (tau >> 2) + 16 * (r & 3) + 4 * (tau & 3) + 2 * (r >> 3);
                e = __uint_as_float(__float_as_uint(e) & ~(unsigned)((qr - keyc) >> 31)); }
            p[r] = e; lsum += e;
        }
        pk[tau][0].x = cvtpk(p[0], p[1]); pk[tau][0].y = cvtpk(p[2], p[3]); pk[tau][0].z = cvtpk(p[4], p[5]); pk[tau][0].w = cvtpk(p[6], p[7]);
        pk[tau][1].x = cvtpk(p[8], p[9]); pk[tau][1].y = cvtpk(p[10], p[11]); pk[tau][1].z = cvtpk(p[12], p[13]); pk[tau][1].w = cvtpk(p[14], p[15]);
    }
}
__device__ __forceinline__ void attn_pv(const LAS unsigned char* vl, const u32x4 (&pk)[8][2], f32x16 (&o)[4], int lane) {
    const int i = lane & 31, hi = lane >> 5, sw = i & 15;
#pragma unroll
    for (int tau = 0; tau < 8; ++tau) {
        const bf16x8 pa0 = __builtin_bit_cast(bf16x8, pk[tau][0]), pa1 = __builtin_bit_cast(bf16x8, pk[tau][1]);
#pragma unroll
        for (int d0 = 0; d0 < 4; ++d0) {
            const LAS unsigned char* vp = vl + (32 * d0 + i) * 512;
            const bf16x8 v0 = *(const LAS bf16x8*)(vp + (((4 * tau + hi) ^ sw) << 4)), v1 = *(const LAS bf16x8*)(vp + (((4 * tau + 2 + hi) ^ sw) << 4));
            o[d0] = __builtin_amdgcn_mfma_f32_32x32x16_bf16(v0, pa0, o[d0], 0, 0, 0);
            o[d0] = __builtin_amdgcn_mfma_f32_32x32x16_bf16(v1, pa1, o[d0], 0, 0, 0);
        }
    }
}
__device__ __forceinline__ void dma_image(LAS unsigned char* dst, const bf16_t* src, int wave, int lane) {
#pragma unroll
    for (int i = 0; i < 8; ++i)
        __builtin_amdgcn_global_load_lds((const unsigned*)((const char*)src + ((i * 8 + wave) * 1024 + lane * 16)), (LAS unsigned*)(dst + (i * 8 + wave) * 1024), 16, 0, 0);
}
#define VM_WAIT0() asm volatile("s_waitcnt vmcnt(0)" ::: "memory")


template <bool LANEMAJOR>
__device__ __forceinline__ void store_rows_staged(LAS unsigned char* stg, const f32x16 (&o)[4], float scale, long rowoff, int sel, bool valid, bf16_t* base0, bf16_t* base1, bf16_t* base2, int lane) {
    const int q = lane & 31, hi = lane >> 5;
    const int lo32 = (int)(unsigned)(rowoff & 0xffffffffl), hi32 = (int)(rowoff >> 32);
    const int meta = valid ? sel : -1;
#pragma unroll
    for (int p = 0; p < 8; ++p) {
        if ((q >> 2) == p) {
            if (LANEMAJOR) {
                LAS unsigned char* wp = stg + (q & 3) * 272 + 128 * hi;
#pragma unroll
                for (int d0 = 0; d0 < 4; ++d0)
#pragma unroll
                    for (int gp = 0; gp < 2; ++gp) { u32x4 w; w.x = cvtpk(o[d0][8 * gp] * scale, o[d0][8 * gp + 1] * scale); w.y = cvtpk(o[d0][8 * gp + 2] * scale, o[d0][8 * gp + 3] * scale);
                        w.z = cvtpk(o[d0][8 * gp + 4] * scale, o[d0][8 * gp + 5] * scale); w.w = cvtpk(o[d0][8 * gp + 6] * scale, o[d0][8 * gp + 7] * scale); *(LAS u32x4*)(wp + 32 * d0 + 16 * gp) = w; }
            } else {
            LAS unsigned char* wp = stg + (q & 3) * 272 + 8 * hi;
#pragma unroll
            for (int d0 = 0; d0 < 4; ++d0)
#pragma unroll
                for (int g = 0; g < 4; ++g) { u32x2 w; w.x = cvtpk(o[d0][4 * g] * scale, o[d0][4 * g + 1] * scale); w.y = cvtpk(o[d0][4 * g + 2] * scale, o[d0][4 * g + 3] * scale); *(LAS u32x2*)(wp + 64 * d0 + 16 * g) = w; }
            }
        }
        asm volatile("s_waitcnt lgkmcnt(0)" ::: "memory");
        const int src = 4 * p + (lane >> 4);
        const int m_ = __shfl(meta, src), l_ = __shfl(lo32, src), h_ = __shfl(hi32, src);
        const u32x4 v = *(const LAS u32x4*)(stg + (lane >> 4) * 272 + (lane & 15) * 16);
        asm volatile("s_waitcnt lgkmcnt(0)" ::: "memory");
        if (m_ >= 0) {
            bf16_t* bp = (m_ == 0) ? base0 : (m_ == 1) ? base1 : base2;
            const long ro = ((long)h_ << 32) | (long)(unsigned)l_;
            *(u32x4*)(bp + ro + (lane & 15) * 8) = v;
        }
    }
}

template <int VAR>
__device__ __forceinline__ void phase_part1(Frame& F, int b) {
    FTID;
    const bf16_t* KN = (const bf16_t*)(F.ws + WS_KN) + (size_t)b * NH * NBLK * (BS * HD); const bf16_t* VT = (const bf16_t*)(F.ws + WS_VT) + (size_t)b * NH * NBLK * (BS * HD);
    const bf16_t* QN = (const bf16_t*)(F.ws + WS_QN) + (size_t)b * NH * T * HD;
    const unsigned* CNT = (const unsigned*)(F.ws + WS_CNT) + b * NH * NBLK; const unsigned short* LIST = (const unsigned short*)(F.ws + WS_LIST) + (size_t)b * NH * NBLK * T;
    float* LS = (float*)(F.ws + WS_LS);
    LAS int* pref = (LAS int*)(F.lds + 131072);
    LAS int* cnl = (LAS int*)(F.lds + 131072 + 2064);
    LAS int* ncs = (LAS int*)(F.lds + 131072 + 4160);
    LAS unsigned char* stg = F.lds + 131072 + 4160 + F.wave * 1088;
    const float c1 = 0.08838834764831845f * 1.4426950408889634f, c2 = *(const float*)(F.ws + WS_CREF);
    __syncthreads();
    { const unsigned c = CNT[f_tid]; cnl[f_tid] = (int)c; ncs[f_tid] = (int)((c + 255u) >> 8); }
    __syncthreads();
    { int s = 0; for (int i = 0; i < f_tid; ++i) s += ncs[i]; pref[f_tid] = s; if (f_tid == 511) pref[512] = s + ncs[511]; }
    __syncthreads();
    const int total = pref[512];
    const int lane = f_lane, q = lane & 31, hi = lane >> 5;
#define P1_FIND(it_, hj_, ch_) do { int lo_ = 0, hi2_ = 511; while (lo_ < hi2_) { const int mid_ = (lo_ + hi2_ + 1) >> 1; if (pref[mid_] <= (it_)) lo_ = mid_; else hi2_ = mid_ - 1; } hj_ = lo_; ch_ = (it_) - pref[lo_]; } while (0)
    const int vcu = ((F.G & 7) == 0) ? (F.bid & 7) * (F.G >> 3) + (F.bid >> 3) : F.bid;
    int it = (int)(((long)total * vcu) / F.G); const int it_end = (int)(((long)total * (vcu + 1)) / F.G);
    if (it >= it_end) return;
    int hj, ch; P1_FIND(it, hj, ch);
    bool newblk = true;
    dma_image(F.lds, KN + (size_t)hj * (BS * HD), F.wave, lane);
    bool valid; int t, r; bf16x8 qf[8];
    { const int li = ch * 256 + F.wave * 32 + q; valid = li < cnl[hj]; const unsigned e = valid ? LIST[(size_t)hj * T + li] : 0u; t = (int)(e >> 2); r = (int)(e & 3);
      const bf16_t* qp = QN + ((size_t)(hj >> 6) * T + t) * HD + 8 * hi;
#pragma unroll
      for (int d0 = 0; d0 < 8; ++d0) qf[d0] = *(const bf16x8*)(qp + 16 * d0); }
    for (;;) {
        const int itn = it + 1; const bool has_next = itn < it_end;
        int hjn = 0, chn = 0; if (has_next) P1_FIND(itn, hjn, chn);
        VM_WAIT0(); __syncthreads();
        if (newblk) dma_image(F.lds + 65536, VT + (size_t)hj * (BS * HD), F.wave, lane);
        bool validn = false; unsigned en = 0u;
        if (has_next) { const int li = chn * 256 + F.wave * 32 + q; validn = li < cnl[hjn]; en = validn ? LIST[(size_t)hjn * T + li] : 0u; }
        u32x4 pk[8][2]; float lsum = 0.f;
        if (VAR < 3) attn_qk<false>(F.lds, qf, pk, lsum, 0, lane, c1, c2);
        else {
#pragma unroll
            for (int a_ = 0; a_ < 8; ++a_) { pk[a_][0] = (u32x4){0u, 0u, 0u, 0u}; pk[a_][1] = (u32x4){0u, 0u, 0u, 0u}; } }
        lsum += __shfl_xor(lsum, 32);
        VM_WAIT0(); __syncthreads();
        const int tn = (int)(en >> 2), rn = (int)(en & 3);
        if (has_next) {
            if (hjn != hj) dma_image(F.lds, KN + (size_t)hjn * (BS * HD), F.wave, lane);
            const bf16_t* qp = QN + ((size_t)(hjn >> 6) * T + tn) * HD + 8 * hi;
#pragma unroll
            for (int d0 = 0; d0 < 8; ++d0) qf[d0] = *(const bf16x8*)(qp + 16 * d0);
        }
        f32x16 o[4]; o[0] = f32x16{}; o[1] = f32x16{}; o[2] = f32x16{}; o[3] = f32x16{};
        if (VAR < 2) attn_pv(F.lds + 65536, pk, o, lane);
        if (VAR < 1) {
            const int h = hj >> 6;
            store_rows_staged<true>(stg, o, 1.0f, ((long)h * T + t) * HD, r, valid, (bf16_t*)(F.ws + WS_XB2), (bf16_t*)(F.ws + WS_XB2 + 32 * MiB), (bf16_t*)(F.ws + WS_SLOT2), lane);
            if (valid && hi == 0) LS[((size_t)r * NH + h) * T + t] = lsum;
        }
        if (!has_next) break;
        newblk = (hjn != hj);
        it = itn; hj = hjn; ch = chn; valid = validn; t = tn; r = rn;
    }
    VM_WAIT0();
    __syncthreads();
#undef P1_FIND
}

__device__ __forceinline__ void phase_part2(Frame& F, int b) {
    FTID;
    const bf16_t* KN = (const bf16_t*)(F.ws + WS_KN) + (size_t)b * NH * NBLK * (BS * HD); const bf16_t* VT = (const bf16_t*)(F.ws + WS_VT) + (size_t)b * NH * NBLK * (BS * HD);
    const bf16_t* QN = (const bf16_t*)(F.ws + WS_QN) + (size_t)b * NH * T * HD;
    const float* LS = (const float*)(F.ws + WS_LS); bf16_t* ATT = (bf16_t*)(F.ws + WS_XB);
    const float c1 = 0.08838834764831845f * 1.4426950408889634f, c2 = *(const float*)(F.ws + WS_CREF);
    const int lane = f_lane, q = lane & 31, hi = lane >> 5;
    const int qrow = F.wave * 32 + q;
    int it = F.bid;
    if (it >= NH * NBLK) return;
    __syncthreads();
    dma_image(F.lds, KN + (size_t)it * (BS * HD), F.wave, lane);
    bf16x8 qf[8];
    { const bf16_t* qp = QN + ((size_t)(it >> 6) * T + (it & 63) * BS + qrow) * HD + 8 * hi;
#pragma unroll
      for (int d0 = 0; d0 < 8; ++d0) qf[d0] = *(const bf16x8*)(qp + 16 * d0); }
    for (;;) {
        const int itn = it + F.G; const bool has_next = itn < NH * NBLK;
        const int h = it >> 6, n = it & 63, t = n * BS + qrow;
        VM_WAIT0(); __syncthreads();
        dma_image(F.lds + 65536, VT + (size_t)it * (BS * HD), F.wave, lane);
        u32x4 pk[8][2]; float lsum = 0.f;
        attn_qk<true>(F.lds, qf, pk, lsum, qrow, lane, c1, c2);
        lsum += __shfl_xor(lsum, 32);
        VM_WAIT0(); __syncthreads();
        if (has_next) {
            dma_image(F.lds, KN + (size_t)itn * (BS * HD), F.wave, lane);
            const bf16_t* qp = QN + ((size_t)(itn >> 6) * T + (itn & 63) * BS + qrow) * HD + 8 * hi;
#pragma unroll
            for (int d0 = 0; d0 < 8; ++d0) qf[d0] = *(const bf16x8*)(qp + 16 * d0);
        }
        f32x16 o[4]; o[0] = f32x16{}; o[1] = f32x16{}; o[2] = f32x16{}; o[3] = f32x16{};
        attn_pv(F.lds + 65536, pk, o, lane);
        const int nsel = n < 3 ? n : 3;
        for (int r = 0; r < nsel; ++r) {
            const bf16_t* sp = (const bf16_t*)(F.ws + (r == 2 ? WS_SLOT2 : WS_XB2 + (size_t)r * 32 * MiB)) + ((size_t)h * T + t) * HD + 64 * hi;
            const float lr = LS[((size_t)r * NH + h) * T + t];
            u32x4 sw_[8];
#pragma unroll
            for (int c = 0; c < 8; ++c) sw_[c] = *(const u32x4*)(sp + 8 * c);
            lsum += lr;
#pragma unroll
            for (int d0 = 0; d0 < 4; ++d0)
#pragma unroll
                for (int gp = 0; gp < 2; ++gp) { const u32x4 w = sw_[2 * d0 + gp];
                    o[d0][8 * gp] += bflo(w.x); o[d0][8 * gp + 1] += bfhi(w.x); o[d0][8 * gp + 2] += bflo(w.y); o[d0][8 * gp + 3] += bfhi(w.y);
                    o[d0][8 * gp + 4] += bflo(w.z); o[d0][8 * gp + 5] += bfhi(w.z); o[d0][8 * gp + 6] += bflo(w.w); o[d0][8 * gp + 7] += bfhi(w.w); }
        }
        const float il = 1.0f / lsum;
        store_rows_staged<false>(F.lds + 131072 + 4160 + F.wave * 1088, o, il, ((long)(b * T + t)) * D + h * HD, 0, true, ATT, ATT, ATT, lane);
        if (!has_next) break;
        it = itn;
    }
    VM_WAIT0();
    __syncthreads();
}

#define XB_TMO      128
#define XB_XCNT(j)  (256  + 64 * (j))
#define XB_XSUB(j)  (1280 + 64 * (j))
#define XB_XGEN(j)  (2304 + 64 * (j))
#define XB_TOP      3328
#define XB_TOPGEN   3392
#define XCD_BAR_WORDS 3456
#define XB_SPIN_CAP (1u << 20)
__device__ __forceinline__ unsigned xb_ld(unsigned* p)              { return __hip_atomic_load(p, __ATOMIC_RELAXED, __HIP_MEMORY_SCOPE_AGENT); }
__device__ __forceinline__ unsigned xb_add(unsigned* p, unsigned v) { return __hip_atomic_fetch_add(p, v, __ATOMIC_RELAXED, __HIP_MEMORY_SCOPE_AGENT); }
__device__ __forceinline__ unsigned xb_xcc_id() { return (unsigned)__builtin_amdgcn_s_getreg((3 << 11) | 20) & 0xFu; }
#define XB_SPIN(cond, bar) do { unsigned _sp = 0; while (cond) { __builtin_amdgcn_s_sleep(1); \
    if ((++_sp & 255u) == 0u) { if (xb_ld(&(bar)[XB_TMO])) break; if (_sp > XB_SPIN_CAP) { atomicAdd(&(bar)[XB_TMO], 1u); break; } } } } while (0)
struct XcdBarrier { unsigned* bar; unsigned x; volatile LAS unsigned* st; };
__device__ __forceinline__ void xcd_barrier_complete(unsigned* bar, unsigned x, unsigned& nloc, unsigned& nx) {
    const unsigned G = gridDim.x;
    unsigned sum, cnt, mine, sp = 0u;
    for (;;) {
        sum = 0u; cnt = 0u; mine = 0u;
#pragma unroll
        for (unsigned j = 0; j < 16; ++j) { const unsigned c = xb_ld(&bar[XB_XCNT(j)]); sum += c; cnt += (c > 0u) ? 1u : 0u; mine = (j == x) ? c : mine; }
        if (sum == G) break;
        __builtin_amdgcn_s_sleep(1);
        if ((++sp & 255u) == 0u) { if (xb_ld(&bar[XB_TMO])) break; if (sp > XB_SPIN_CAP) { atomicAdd(&bar[XB_TMO], 1u); break; } }
    }
    nloc = mine > 0u ? mine : 1u; nx = cnt > 0u ? cnt : 1u;
}
__device__ __forceinline__ void xcd_barrier(const XcdBarrier& b, int tid) {
    asm volatile("s_waitcnt vmcnt(0)" ::: "memory");
    __syncthreads();
    if (tid == 0) {
        unsigned* bar = b.bar;
        __builtin_amdgcn_s_waitcnt(0);
        unsigned nloc = b.st[0], nx = b.st[1];
        if (nloc == 0u) { xcd_barrier_complete(bar, b.x, nloc, nx); b.st[0] = nloc; b.st[1] = nx; }
        const unsigned old = xb_add(&bar[XB_XSUB(b.x)], 1u);
        const unsigned gen = old / nloc;
        if (old + 1u == (gen + 1u) * nloc) {
            __builtin_amdgcn_fence(__ATOMIC_RELEASE, "agent");
            asm volatile("s_waitcnt vmcnt(0)" ::: "memory");
            const unsigned og = xb_add(&bar[XB_TOP], 1u);
            const unsigned tg = og / nx;
            if (og + 1u == (tg + 1u) * nx) xb_add(&bar[XB_TOPGEN], 1u);
            else XB_SPIN(xb_ld(&bar[XB_TOPGEN]) == tg, bar);
            __builtin_amdgcn_fence(__ATOMIC_ACQUIRE, "agent");
            xb_add(&bar[XB_XGEN(b.x)], 1u);
            asm volatile("s_waitcnt vmcnt(0)" ::: "memory");
        } else {
            XB_SPIN(xb_ld(&bar[XB_XGEN(b.x)]) == gen, bar);
            __builtin_amdgcn_fence(__ATOMIC_ACQUIRE, "agent");
            asm volatile("s_waitcnt vmcnt(0)" ::: "memory");
        }
    }
    __syncthreads();
}

__global__ void __launch_bounds__(512, 2) fwd_kernel(Args args) {
    extern __shared__ __attribute__((aligned(16))) unsigned char lds_raw[];
    Frame F;
    F.lds = (LAS unsigned char*)lds_raw;
    F.wave = __builtin_amdgcn_readfirstlane(threadIdx.x >> 6);
    F.G = gridDim.x; F.bid = blockIdx.x; F.ws = args.ws;
    unsigned char* ws = args.ws;
    const int lo = args.ph_lo, hi = args.ph_hi;
    XcdBarrier bar; bar.bar = (unsigned*)(ws + WS_BAR); bar.st = (volatile LAS unsigned*)(F.lds + LDS_BYTES - 64); bar.x = xb_xcc_id();
#if MK_COOP
    if (hi > NPH) cg::this_grid().sync();
    if (threadIdx.x == 0) { bar.st[0] = 0u; bar.st[1] = 0u; (void)xb_add(&bar.bar[XB_XCNT(bar.x)], 1u); }
#endif
    const float* VEC = (const float*)(ws + WS_VEC); const float* BIAS = (const float*)(ws + WS_BIAS);
    float* SSQA = (float*)(ws + WS_SSQA); float* SSQB = (float*)(ws + WS_SSQB);
    bf16_t* XB = (bf16_t*)(ws + WS_XB); bf16_t* XB2 = (bf16_t*)(ws + WS_XB2); bf16_t* ACT = (bf16_t*)(ws + WS_BIG);
    const bf16_t* WIN = (const bf16_t*)(ws + WS_WIN); const bf16_t* WOUT = (const bf16_t*)(ws + WS_WOUT);
    float* X = args.out;
    bf16_t* X16 = (bf16_t*)args.out;
    bf16_t* X5 = (bf16_t*)(ws + WS_SLOT2);
    LAS float* RED = (LAS float*)(F.lds + 131072 + 4096);
#define VWK(sub) (VEC + ((0 * 7 + (sub)) * 2) * D)
#define VGC(sub) (VEC + ((2 * 7 + (sub)) * 2) * D)
#if MK_COOP
#define SEAM(k) do { if ((k) + 1 < hi) xcd_barrier(bar, F.wave * 64 + lane_id()); } while (0)
#else
#define SEAM(k) do { } while (0)
#endif
#ifndef PHMASK
#define PHMASK 0xffffffffu
#endif
#define IN(k) (((PHMASK >> (k)) & 1u) && lo <= (k) && (k) < hi)
#define GEMM1(f, A_, ssq_) do { pg8::Gemm g{A_, WIN + (size_t)(f) * NIN * D, M, NIN, D, D, 0}; pg8::StaticOrder S; S.init(M, NIN, F.G, F.bid); \
        pg8::EpiSwiglu E{ACT, BIAS + (f) * 2 * NIN, ssq_}; pg8::gemm_phase(F.lds, g, S, E, F.wave); } while (0)
#define GEMM2(IN16_, OUT16_, f, xin_, xout_, sub_, xb1_, wk1_, xb2_, wk2_, ssq_) do { pg8::Gemm g{ACT, WOUT + (size_t)(f) * D * FF, M, D, FF, FF, 0}; pg8::StaticOrder S; S.init(M, D, F.G, F.bid, 1); \
        pg8::EpiResid<IN16_, OUT16_> E{xin_, xout_, VGC(sub_), xb1_, wk1_, xb2_, wk2_, ssq_, RED}; pg8::gemm_phase(F.lds, g, S, E, F.wave); } while (0)

#ifndef DUPMASK
#define DUPMASK 0u
#endif
#if MK_COOP
#define DUPBAR() xcd_barrier(bar, F.wave * 64 + lane_id())
#else
#define DUPBAR() do { } while (0)
#endif
#define PH(k, ...) if (IN(k)) { __VA_ARGS__; if ((DUPMASK >> (k)) & 1u) { DUPBAR(); __VA_ARGS__; } SEAM(k); }
    PH(0, phase0(F, args))
    PH(1, phase1(F, args))
    PH(2, phase2(F, args))
    PH(3, GEMM1(0, XB, SSQA))
    PH(4, GEMM2(false, true, 0, args.in[0], X16, 0, (bf16_t*)nullptr, (const float*)nullptr, (bf16_t*)nullptr, (const float*)nullptr, SSQB))
    PH(5, phase_pool_elem(F, X16, SSQB))
    PH(6, { pg8::Gemm g{XB2, (const bf16_t*)(ws + WS_WPOOL), M, D, 256, D, 256}; pg8::StaticOrder S; S.init(M, D, F.G, F.bid, 1);
        pg8::EpiResid<true, true> E{X16, X16, VGC(1), XB, VWK(2), (bf16_t*)nullptr, (const float*)nullptr, SSQA, RED}; pg8::gemm_phase(F.lds, g, S, E, F.wave); })
    PH(7, GEMM1(1, XB, SSQA))
    PH(8, GEMM2(true, true, 1, X16, X16, 2, XB, VWK(3), XB2, VWK(6), SSQB))
    PH(9, GEMM1(2, XB, SSQB))
    PH(10, GEMM2(true, true, 2, X16, X16, 3, XB, VWK(4), (bf16_t*)nullptr, (const float*)nullptr, SSQA))
    PH(11, {
        { pg8::Gemm g{XB, (const bf16_t*)(ws + WS_WQ), M, D, D, D, 0}; pg8::StaticOrder S; S.init(M, D, F.G, F.bid);
          pg8::EpiProj E{BIAS + 8 * NIN + 4 * D, D, SSQA, (bf16_t*)(ws + WS_QN), (bf16_t*)nullptr}; pg8::gemm_phase(F.lds, g, S, E, F.wave); }
        { pg8::Gemm g{XB2, (const bf16_t*)(ws + WS_WKV), M, 2 * D, D, D, 0}; pg8::StaticOrder S; S.init(M, 2 * D, F.G, F.bid);
          pg8::EpiProj E{BIAS + 8 * NIN, 2 * D, SSQB, (bf16_t*)(ws + WS_KN), (bf16_t*)(ws + WS_VT)}; pg8::gemm_phase(F.lds, g, S, E, F.wave); } })
#if defined(PROBE_KVPREP)
    PH(12, { phase_kvprep(F, args); DUPBAR();
        { pg8::Gemm g{XB2, (const bf16_t*)(ws + WS_WKV), M, 2 * D, D, D, 0}; pg8::StaticOrder S; S.init(M, 2 * D, F.G, F.bid);
          pg8::EpiProj E{BIAS + 8 * NIN, 2 * D, SSQB, (bf16_t*)(ws + WS_KN), (bf16_t*)(ws + WS_VT)}; pg8::gemm_phase(F.lds, g, S, E, F.wave); }
        DUPBAR(); phase_kvprep(F, args); })
#else
    PH(12, phase_kvprep(F, args))
#endif
    PH(13, phase_sel(F, args))
#ifndef P1VAR
#define P1VAR 0
#endif
    if (IN(14)) { phase_part1<0>(F, 0); if (P1VAR) { DUPBAR(); phase_part1<P1VAR>(F, 0); } SEAM(14); }
    PH(15, phase_part2(F, 0))
    PH(16, phase_part1<0>(F, 1))
    PH(17, phase_part2(F, 1))
    PH(18, { pg8::Gemm g{XB, (const bf16_t*)(ws + WS_WO), M, D, D, D, 0}; pg8::StaticOrder S; S.init(M, D, F.G, F.bid, 1);
        pg8::EpiResid<true, true> E{X16, X5, VGC(4), XB2, VWK(5), (bf16_t*)nullptr, (const float*)nullptr, SSQA, RED}; pg8::gemm_phase(F.lds, g, S, E, F.wave); })
    PH(19, GEMM1(3, XB2, SSQA))
    PH(20, GEMM2(true, false, 3, X5, X, 5, (bf16_t*)nullptr, (const float*)nullptr, (bf16_t*)nullptr, (const float*)nullptr, (float*)nullptr))
}

extern "C" void kernel_launch(void* const* d_in, const int* in_sizes, int n_in, void* d_out, int out_size, void* d_ws, size_t ws_size, hipStream_t stream) {
    static int grid = 0;
    if (grid == 0) {
        if (n_in != 17 || in_sizes[0] != M * D || out_size != M * D || ws_size < WS_END) { fprintf(stderr, "kernel_launch: unexpected shapes (n_in %d, in0 %d, out %d, ws %zu < %zu)\n", n_in, n_in > 0 ? in_sizes[0] : -1, out_size, ws_size, (size_t)WS_END); grid = -1; return; }
        int dev = 0, cus = 0, per_cu = 0;
        if (hipGetDevice(&dev) != hipSuccess || hipDeviceGetAttribute(&cus, hipDeviceAttributeMultiprocessorCount, dev) != hipSuccess) { grid = -1; return; }
        if (hipFuncSetAttribute((const void*)fwd_kernel, hipFuncAttributeMaxDynamicSharedMemorySize, LDS_BYTES) != hipSuccess) { fprintf(stderr, "kernel_launch: hipFuncSetAttribute failed\n"); grid = -1; return; }
        if (hipOccupancyMaxActiveBlocksPerMultiprocessor(&per_cu, (const void*)fwd_kernel, 512, LDS_BYTES) != hipSuccess || per_cu < 1) { fprintf(stderr, "kernel_launch: occupancy query says %d\n", per_cu); per_cu = 1; }
        (void)hipGetLastError();
        grid = cus * 1;
    }
    if (grid < 0) return;
    if (hipMemsetAsync(d_ws, 0, 65536, stream) != hipSuccess) { fprintf(stderr, "kernel_launch: memset failed\n"); return; }
    Args a{};
    for (int i = 0; i < 17; ++i) a.in[i] = (const float*)d_in[i];
    a.out = (float*)d_out; a.ws = (unsigned char*)d_ws;
#if MK_COOP
    a.ph_lo = 0; a.ph_hi = NPH;
    void* kargs[] = {&a};
    hipError_t e = hipLaunchCooperativeKernel((const void*)fwd_kernel, dim3(grid), dim3(512), kargs, LDS_BYTES, stream);
    if (e != hipSuccess) fprintf(stderr, "cooperative launch failed: %s (grid %d)\n", hipGetErrorString(e), grid);
#else
    for (int p = 0; p < NPH; ++p) { a.ph_lo = p; a.ph_hi = p + 1; hipLaunchKernelGGL(fwd_kernel, dim3(grid), dim3(512), LDS_BYTES, stream, a); }
#endif
}
```
